# Optimizing an MI355X kernel written in HIP

```python
import math
import jax, jax.numpy as jnp
from jax import lax
import numpy as np

D_MODEL = 1024
BATCH = 8
SEQ = 2048
DEPTH = 1
DEC_BATCH = 128
DEC_SEQ = 1
PAST_LEN = 8192
PAGE_SIZE = 128

D_MIX = 2 * D_MODEL
D_ATTN = D_MIX // 2
D_SSM = D_MIX - D_ATTN
MLA_HEADS = 8
QK_NOPE = 128
QK_ROPE = 64
V_HEAD = D_ATTN // MLA_HEADS
Q_RANK = 384
KV_RANK = 256
ROPE_THETA = 10000.0
SOFTMAX_SCALE = (QK_NOPE + QK_ROPE) ** -0.5
SSD_HEADDIM = 64
SSD_HEADS = D_SSM // SSD_HEADDIM
SSD_GROUPS = 2
HEADS_PER_GROUP = SSD_HEADS // SSD_GROUPS
D_STATE = 128
CONV_W = 4
CONV_DIM = D_SSM + 2 * SSD_GROUPS * D_STATE
CHUNK = 128
Q_BLOCK = 128
EPS = 1e-6
NEG_BIG = -1e30
SPLIT_POINTS = (Q_RANK,
                Q_RANK + KV_RANK,
                Q_RANK + KV_RANK + QK_ROPE,
                Q_RANK + KV_RANK + QK_ROPE + D_ATTN,
                Q_RANK + KV_RANK + QK_ROPE + D_ATTN + D_SSM,
                Q_RANK + KV_RANK + QK_ROPE + D_ATTN + D_SSM + CONV_DIM)
D_IN_PROJ = SPLIT_POINTS[-1] + SSD_HEADS

kernel_name = 'hymba_mla_ssd_decode_step'


def _rmsnorm(x, w):
    xf = x.astype(jnp.float32)
    y = xf * lax.rsqrt(jnp.mean(xf * xf, axis=-1, keepdims=True) + EPS)
    return (y * w.astype(jnp.float32)).astype(x.dtype)


def _rope(x, pos):
    half = QK_ROPE // 2
    inv_freq = ROPE_THETA ** (-jnp.arange(half, dtype=jnp.float32) / half)
    ang = pos.astype(jnp.float32)[:, None] * inv_freq[None, :]
    cos = jnp.cos(ang)[None, :, None, :]
    sin = jnp.sin(ang)[None, :, None, :]
    xf = x.astype(jnp.float32)
    x1, x2 = xf[..., :half], xf[..., half:]
    return jnp.concatenate([x1 * cos - x2 * sin, x1 * sin + x2 * cos], axis=-1).astype(x.dtype)


def _in_projection(x, lw):
    h = _rmsnorm(x, lw['norm_pre'])
    return jnp.split(h @ lw['w_in'], SPLIT_POINTS, axis=-1)


def _mla_qk(q_a, c_raw, kr_raw, pos, lw):
    b, s, _ = q_a.shape
    q = (_rmsnorm(q_a, lw['q_a_norm']) @ lw['w_q_b']).reshape(b, s, MLA_HEADS, QK_NOPE + QK_ROPE)
    q_rope = _rope(q[..., QK_NOPE:], pos)
    q_lat = jnp.einsum('bshn,rhn->bshr', q[..., :QK_NOPE], lw['w_uk'])
    ckv = _rmsnorm(c_raw, lw['kv_a_norm'])
    k_rope = _rope(kr_raw[:, :, None, :], pos)[:, :, 0, :]
    return q_lat, q_rope, ckv, k_rope


def _latent_attention(q_lat, q_rope, ckv, k_rope, q_pos, k_pos):
    sc = (jnp.einsum('bqhr,bkr->bhqk', q_lat, ckv)
          + jnp.einsum('bqhe,bke->bhqk', q_rope, k_rope)).astype(jnp.float32) * SOFTMAX_SCALE
    sc = jnp.where(k_pos[None, None, None, :] <= q_pos[None, None, :, None], sc, NEG_BIG)
    p = jax.nn.softmax(sc, axis=-1).astype(ckv.dtype)
    return jnp.einsum('bhqk,bkr->bqhr', p, ckv)


def _mla_out(o_lat, z_attn, lw):
    b, s = o_lat.shape[:2]
    o = jnp.einsum('bshr,rhv->bshv', o_lat, lw['w_uv']).reshape(b, s, D_ATTN)
    return o * jax.nn.silu(z_attn)


def _causal_conv(xbc, prev, lw):
    s = xbc.shape[1]
    xp = jnp.concatenate([prev.astype(xbc.dtype), xbc], axis=1)
    w = lw['conv_w']
    acc = lw['conv_b'] + xp[:, 0:s, :] * w[0]
    for k in range(1, CONV_W):
        acc = acc + xp[:, k:k + s, :] * w[k]
    return jax.nn.silu(acc), xp[:, -(CONV_W - 1):, :]


def _ssd_pre(xbc_act, dt_raw, lw):
    b, s, _ = xbc_act.shape
    f = xbc_act.astype(jnp.float32)
    xs = f[..., :D_SSM].reshape(b, s, SSD_GROUPS, HEADS_PER_GROUP, SSD_HEADDIM)
    bm = f[..., D_SSM:D_SSM + SSD_GROUPS * D_STATE].reshape(b, s, SSD_GROUPS, D_STATE)
    cm = f[..., D_SSM + SSD_GROUPS * D_STATE:].reshape(b, s, SSD_GROUPS, D_STATE)
    dt = jax.nn.softplus(dt_raw.astype(jnp.float32) + lw['dt_bias'].astype(jnp.float32))
    dt = dt.reshape(b, s, SSD_GROUPS, HEADS_PER_GROUP)
    a = -jnp.exp(lw['a_log'].astype(jnp.float32)).reshape(SSD_GROUPS, HEADS_PER_GROUP)
    return xs, bm, cm, dt, dt * a


def _segsum(x):
    t = x.shape[-1]
    xr = jnp.broadcast_to(x[..., :, None], x.shape + (t,))
    idx = jnp.arange(t)
    cs = jnp.cumsum(jnp.where(idx[:, None] > idx[None, :], xr, 0.0), axis=-2)
    return jnp.where(idx[:, None] >= idx[None, :], cs, -jnp.inf)


def _ssd_chunked(xs, dt, da, bm, cm):
    b, s = xs.shape[:2]
    nc = s // CHUNK
    xdt = (xs * dt[..., None]).reshape(b, nc, CHUNK, SSD_GROUPS, HEADS_PER_GROUP, SSD_HEADDIM)
    a = da.reshape(b, nc, CHUNK, SSD_GROUPS, HEADS_PER_GROUP).transpose(0, 3, 4, 1, 2)
    bc = bm.reshape(b, nc, CHUNK, SSD_GROUPS, D_STATE)
    cc = cm.reshape(b, nc, CHUNK, SSD_GROUPS, D_STATE)
    a_cum = jnp.cumsum(a, axis=-1)
    decay_in = jnp.exp(_segsum(a))
    cb = jnp.einsum('bclgn,bcsgn->bcgls', cc, bc)
    y_diag = jnp.einsum('bcgls,bgjcls,bcsgjp->bclgjp', cb, decay_in, xdt)
    decay_to_end = jnp.exp(a_cum[..., -1:] - a_cum)
    chunk_states = jnp.einsum('bclgn,bgjcl,bclgjp->bcgjpn', bc, decay_to_end, xdt)
    chunk_states = jnp.concatenate([jnp.zeros_like(chunk_states[:, :1]), chunk_states], axis=1)
    decay_chunk = jnp.exp(_segsum(jnp.pad(a_cum[..., -1], ((0, 0), (0, 0), (0, 0), (1, 0)))))
    states = jnp.einsum('bgjzc,bcgjpn->bzgjpn', decay_chunk, chunk_states)
    y_off = jnp.einsum('bclgn,bcgjpn,bgjcl->bclgjp', cc, states[:, :-1], jnp.exp(a_cum))
    y = (y_diag + y_off).reshape(b, s, SSD_GROUPS, HEADS_PER_GROUP, SSD_HEADDIM)
    return y, states[:, -1]


def _ssd_recurrent(xs, dt, da, bm, cm, h0):
    def step(h, inp):
        x_t, dt_t, da_t, b_t, c_t = inp
        h = jnp.exp(da_t)[..., None, None] * h + jnp.einsum('bgjp,bgn->bgjpn', x_t * dt_t[..., None], b_t)
        return h, jnp.einsum('bgjpn,bgn->bgjp', h, c_t)
    seq_major = tuple(jnp.swapaxes(v, 0, 1) for v in (xs, dt, da, bm, cm))
    h, ys = lax.scan(step, h0, seq_major)
    return jnp.swapaxes(ys, 0, 1), h


def _ssd_out(y, xs, z_ssm, lw):
    b, s = y.shape[:2]
    d = lw['d_skip'].astype(jnp.float32).reshape(SSD_GROUPS, HEADS_PER_GROUP)[..., None]
    y = (y + d * xs).reshape(b, s, D_SSM)
    gated = (y * jax.nn.silu(z_ssm.astype(jnp.float32))).reshape(b, s, SSD_GROUPS, D_SSM // SSD_GROUPS)
    out = _rmsnorm(gated, lw['ssm_norm'].reshape(SSD_GROUPS, D_SSM // SSD_GROUPS))
    return out.reshape(b, s, D_SSM).astype(z_ssm.dtype)


def _merge(x, o_attn, y_ssm, lw):
    mix = jnp.concatenate([o_attn, y_ssm], axis=-1)
    return x + _rmsnorm(mix @ lw['w_out'], lw['norm_post'])


def _prompt_layer(x, lw):
    b, s, _ = x.shape
    pos = jnp.arange(s, dtype=jnp.int32)
    q_a, c_raw, kr_raw, z_attn, z_ssm, xbc, dt_raw = _in_projection(x, lw)
    q_lat, q_rope, ckv, k_rope = _mla_qk(q_a, c_raw, kr_raw, pos, lw)
    nb = s // Q_BLOCK
    blocks = (q_lat.reshape(b, nb, Q_BLOCK, MLA_HEADS, KV_RANK).swapaxes(0, 1),
              q_rope.reshape(b, nb, Q_BLOCK, MLA_HEADS, QK_ROPE).swapaxes(0, 1),
              pos.reshape(nb, Q_BLOCK))
    o_lat = lax.map(lambda blk: _latent_attention(blk[0], blk[1], ckv, k_rope, blk[2], pos), blocks)
    o_lat = o_lat.swapaxes(0, 1).reshape(b, s, MLA_HEADS, KV_RANK)
    o_attn = _mla_out(o_lat, z_attn, lw)
    conv_prev = jnp.zeros((b, CONV_W - 1, CONV_DIM), xbc.dtype)
    xbc_act, conv_state = _causal_conv(xbc, conv_prev, lw)
    xs, bm, cm, dt, da = _ssd_pre(xbc_act, dt_raw, lw)
    y, h_final = _ssd_chunked(xs, dt, da, bm, cm)
    y_ssm = _ssd_out(y, xs, z_ssm, lw)
    out = _merge(x, o_attn, y_ssm, lw)
    return out, ckv, k_rope, conv_state, h_final.reshape(b, SSD_HEADS, SSD_HEADDIM, D_STATE)


def _sample_layer(x, cache_ckv, cache_krope, conv_prev, h0, page_table, lw):
    b, s, _ = x.shape
    past = page_table.shape[1] * PAGE_SIZE
    pos = past + jnp.arange(s, dtype=jnp.int32)
    q_a, c_raw, kr_raw, z_attn, z_ssm, xbc, dt_raw = _in_projection(x, lw)
    q_lat, q_rope, ckv, k_rope = _mla_qk(q_a, c_raw, kr_raw, pos, lw)
    ckv_past = cache_ckv[page_table].reshape(b, past, KV_RANK)
    kr_past = cache_krope[page_table].reshape(b, past, QK_ROPE)
    keys_c = jnp.concatenate([ckv_past.astype(ckv.dtype), ckv], axis=1)
    keys_r = jnp.concatenate([kr_past.astype(k_rope.dtype), k_rope], axis=1)
    k_pos = jnp.arange(past + s, dtype=jnp.int32)
    o_lat = _latent_attention(q_lat, q_rope, keys_c, keys_r, pos, k_pos)
    o_attn = _mla_out(o_lat, z_attn, lw)
    xbc_act, conv_state = _causal_conv(xbc, conv_prev, lw)
    xs, bm, cm, dt, da = _ssd_pre(xbc_act, dt_raw, lw)
    h_init = h0.astype(jnp.float32).reshape(b, SSD_GROUPS, HEADS_PER_GROUP, SSD_HEADDIM, D_STATE)
    y, h = _ssd_recurrent(xs, dt, da, bm, cm, h_init)
    y_ssm = _ssd_out(y, xs, z_ssm, lw)
    out = _merge(x, o_attn, y_ssm, lw)
    return out, ckv, k_rope, conv_state, h.reshape(b, SSD_HEADS, SSD_HEADDIM, D_STATE)


def setup_inputs(seed: int = 0) -> dict:
    key = jax.random.key(seed)
    ks = jax.random.split(key, 24)
    f32 = jnp.float32
    n_pages = PAST_LEN // PAGE_SIZE
    n_used = DEC_BATCH * n_pages
    n_phys = n_used + n_used // 4

    def nrm(k, shape, scale):
        return jax.random.normal(k, shape, f32) * scale

    def gain(k, n):
        return 1.0 + 0.05 * jax.random.normal(k, (DEPTH, n), f32)

    page_table = jax.random.permutation(ks[0], n_phys)[:n_used].reshape(DEC_BATCH, n_pages).astype(jnp.int32)
    dt0 = jnp.exp(jax.random.uniform(ks[1], (DEPTH, SSD_HEADS), f32, math.log(1e-3), math.log(1e-1)))
    dt_bias = dt0 + jnp.log(-jnp.expm1(-dt0))
    a_log = jnp.log(jax.random.uniform(ks[2], (DEPTH, SSD_HEADS), f32, 1.0, 16.0))
    return {
        'x_prompt': nrm(ks[3], (BATCH, SEQ, D_MODEL), 1.0),
        'x_sample': nrm(ks[4], (DEC_BATCH, DEC_SEQ, D_MODEL), 1.0),
        'cache_ckv': nrm(ks[5], (DEPTH, n_phys, PAGE_SIZE, KV_RANK), 1.0),
        'cache_krope': nrm(ks[6], (DEPTH, n_phys, PAGE_SIZE, QK_ROPE), 1.0),
        'state_conv': nrm(ks[7], (DEPTH, DEC_BATCH, CONV_W - 1, CONV_DIM), 1.0),
        'state_ssm': nrm(ks[8], (DEPTH, DEC_BATCH, SSD_HEADS, SSD_HEADDIM, D_STATE), 0.1),
        'page_table': page_table,
        'norm_pre': gain(ks[9], D_MODEL),
        'w_in': nrm(ks[10], (DEPTH, D_MODEL, D_IN_PROJ), D_MODEL ** -0.5),
        'q_a_norm': gain(ks[11], Q_RANK),
        'w_q_b': nrm(ks[12], (DEPTH, Q_RANK, MLA_HEADS * (QK_NOPE + QK_ROPE)), Q_RANK ** -0.5),
        'kv_a_norm': gain(ks[13], KV_RANK),
        'w_uk': nrm(ks[14], (DEPTH, KV_RANK, MLA_HEADS, QK_NOPE), KV_RANK ** -0.5),
        'w_uv': nrm(ks[15], (DEPTH, KV_RANK, MLA_HEADS, V_HEAD), KV_RANK ** -0.5),
        'conv_w': nrm(ks[16], (DEPTH, CONV_W, CONV_DIM), CONV_W ** -0.5),
        'conv_b': nrm(ks[17], (DEPTH, CONV_DIM), 0.02),
        'dt_bias': dt_bias,
        'a_log': a_log,
        'd_skip': 1.0 + 0.1 * jax.random.normal(ks[18], (DEPTH, SSD_HEADS), f32),
        'ssm_norm': gain(ks[19], D_SSM),
        'w_out': nrm(ks[20], (DEPTH, D_MIX, D_MODEL), D_MIX ** -0.5),
        'norm_post': gain(ks[21], D_MODEL),
    }


def reference(x_prompt, x_sample, cache_ckv, cache_krope, state_conv, state_ssm, page_table,
              norm_pre, w_in, q_a_norm, w_q_b, kv_a_norm, w_uk, w_uv, conv_w, conv_b,
              dt_bias, a_log, d_skip, ssm_norm, w_out, norm_post):
    y_prompt, y_sample = x_prompt, x_sample
    ckv_p, kr_p, conv_p, ssm_p = [], [], [], []
    ckv_s, kr_s, conv_s, ssm_s = [], [], [], []
    for l in range(DEPTH):
        lw = {'norm_pre': norm_pre[l], 'w_in': w_in[l], 'q_a_norm': q_a_norm[l], 'w_q_b': w_q_b[l],
              'kv_a_norm': kv_a_norm[l], 'w_uk': w_uk[l], 'w_uv': w_uv[l], 'conv_w': conv_w[l],
              'conv_b': conv_b[l], 'dt_bias': dt_bias[l], 'a_log': a_log[l], 'd_skip': d_skip[l],
              'ssm_norm': ssm_norm[l], 'w_out': w_out[l], 'norm_post': norm_post[l]}
        y_prompt, c1, k1, v1, h1 = _prompt_layer(y_prompt, lw)
        y_sample, c2, k2, v2, h2 = _sample_layer(y_sample, cache_ckv[l], cache_krope[l], state_conv[l],
                                                 state_ssm[l], page_table, lw)
        ckv_p.append(c1); kr_p.append(k1); conv_p.append(v1); ssm_p.append(h1)
        ckv_s.append(c2); kr_s.append(k2); conv_s.append(v2); ssm_s.append(h2)
    ckv_prompt, krope_prompt = jnp.stack(ckv_p), jnp.stack(kr_p)
    conv_prompt, ssm_prompt = jnp.stack(conv_p), jnp.stack(ssm_p)
    ckv_sample, krope_sample = jnp.stack(ckv_s), jnp.stack(kr_s)
    conv_sample, ssm_sample = jnp.stack(conv_s), jnp.stack(ssm_s)
    return (y_prompt, y_sample, ckv_prompt, krope_prompt, conv_prompt, ssm_prompt,
            ckv_sample, krope_sample, conv_sample, ssm_sample)
```

```cpp
#include <hip/hip_runtime.h>
#include <cstdint>
#include <cstdio>

namespace ref {
constexpr int D_MODEL = 1024, BATCH = 8, SEQ = 2048, DEC = 128, PAST = 8192, PAGE = 128, NPAGES = 64;
constexpr int NTOK = BATCH * SEQ, MT = NTOK + DEC;
constexpr int HEADS = 8, NOPE = 128, ROPE = 64, QRANK = 384, KVR = 256, VH = 128, DATTN = 1024, DSSM = 1024, DMIX = 2048;
constexpr int SH = 16, HD = 64, NG = 2, DSTATE = 128, CONVD = 1536, NPROJ = 4304;
constexpr int C_QA = 0, C_CR = 384, C_KR = 640, C_ZA = 704, C_ZS = 1728, C_XBC = 2752, C_DT = 4288;
constexpr float EPS = 1e-6f;
constexpr int QK = KVR + ROPE;

template <bool TRANSB>
__global__ void __launch_bounds__(256) gemm_f32(const float* __restrict__ A, const float* __restrict__ B, float* __restrict__ C, int M, int N, int K,
                                                int lda, int ldb, int ldc, long sA, long sB, long sC) {
    __shared__ float As[16][65], Bs[16][65];
    A += sA * blockIdx.z; B += sB * blockIdx.z; C += sC * blockIdx.z;
    const int tx = threadIdx.x & 15, ty = threadIdx.x >> 4, m0 = blockIdx.y * 64, n0 = blockIdx.x * 64;
    float acc[4][4] = {};
    for (int k0 = 0; k0 < K; k0 += 16) {
        for (int i = threadIdx.x; i < 1024; i += 256) {
            const int mm = i >> 4, kk = i & 15; const int m = m0 + mm;
            As[kk][mm] = (m < M) ? A[(long)m * lda + k0 + kk] : 0.f;
        }
        if (TRANSB) { for (int i = threadIdx.x; i < 1024; i += 256) { const int nn = i >> 4, kk = i & 15; const int n = n0 + nn; Bs[kk][nn] = (n < N) ? B[(long)n * ldb + k0 + kk] : 0.f; } }
        else        { for (int i = threadIdx.x; i < 1024; i += 256) { const int kk = i >> 6, nn = i & 63; const int n = n0 + nn; Bs[kk][nn] = (n < N) ? B[(long)(k0 + kk) * ldb + n] : 0.f; } }
        __syncthreads();
#pragma unroll
        for (int kk = 0; kk < 16; ++kk) {
            float a[4], b[4];
#pragma unroll
            for (int i = 0; i < 4; ++i) { a[i] = As[kk][ty * 4 + i]; b[i] = Bs[kk][tx * 4 + i]; }
#pragma unroll
            for (int i = 0; i < 4; ++i)
#pragma unroll
                for (int j = 0; j < 4; ++j) acc[i][j] += a[i] * b[j];
        }
        __syncthreads();
    }
#pragma unroll
    for (int i = 0; i < 4; ++i) { const int m = m0 + ty * 4 + i; if (m >= M) continue;
#pragma unroll
        for (int j = 0; j < 4; ++j) { const int n = n0 + tx * 4 + j; if (n < N) C[(long)m * ldc + n] = acc[i][j]; } }
}

__device__ __forceinline__ float block_sum256(float v, float* sh) {
    for (int o = 32; o > 0; o >>= 1) v += __shfl_xor(v, o);
    __syncthreads();
    if ((threadIdx.x & 63) == 0) sh[threadIdx.x >> 6] = v;
    __syncthreads();
    return sh[0] + sh[1] + sh[2] + sh[3];
}
__global__ void __launch_bounds__(256) rmsnorm_rows(const float* in, long ld_in, const float* w, float* out, long ld_out, float* out2, long ld_out2, int ncols) {
    __shared__ float sh[4];
    const float* r = in + (long)blockIdx.x * ld_in;
    float s = 0.f; for (int c = threadIdx.x; c < ncols; c += 256) { const float v = r[c]; s += v * v; }
    s = block_sum256(s, sh);
    const float rstd = 1.0f / sqrtf(s / (float)ncols + EPS);
    for (int c = threadIdx.x; c < ncols; c += 256) { const float v = r[c] * rstd * w[c]; out[(long)blockIdx.x * ld_out + c] = v; if (out2) out2[(long)blockIdx.x * ld_out2 + c] = v; }
}
__device__ __forceinline__ float siluf(float v) { return v / (1.0f + expf(-v)); }
__device__ __forceinline__ int tok_pos(int row) { return row < NTOK ? (row % SEQ) : PAST; }
__device__ __forceinline__ void rope_cs(int pos, int j, float& c, float& s) {
    const double inv = exp(-(double)j / 32.0 * log(10000.0)); const double a = (double)pos * inv; c = (float)cos(a); s = (float)sin(a);
}
__global__ void rope_q(const float* q192, float* qcat) {
    const int row = blockIdx.x, h = threadIdx.x >> 5, j = threadIdx.x & 31;
    float c, s; rope_cs(tok_pos(row), j, c, s);
    const float x1 = q192[(long)row * 1536 + h * 192 + 128 + j], x2 = q192[(long)row * 1536 + h * 192 + 160 + j];
    qcat[((long)row * 8 + h) * QK + 256 + j] = x1 * c - x2 * s; qcat[((long)row * 8 + h) * QK + 288 + j] = x1 * s + x2 * c;
}
__global__ void rope_k(const float* proj, float* kcat, float* out_p, float* out_s) {
    const int row = blockIdx.x * 8 + (threadIdx.x >> 5), j = threadIdx.x & 31; if (row >= MT) return;
    float c, s; rope_cs(tok_pos(row), j, c, s);
    const float x1 = proj[(long)row * NPROJ + C_KR + j], x2 = proj[(long)row * NPROJ + C_KR + 32 + j];
    const float a = x1 * c - x2 * s, b = x1 * s + x2 * c;
    kcat[(long)row * QK + 256 + j] = a; kcat[(long)row * QK + 288 + j] = b;
    float* o = row < NTOK ? out_p + (long)row * 64 : out_s + (long)(row - NTOK) * 64; o[j] = a; o[32 + j] = b;
}
__global__ void __launch_bounds__(256) qlat_k(const float* q192, const float* w_uk, float* qcat) {
    __shared__ float qs[8][128];
    const int row = blockIdx.x;
    for (int i = threadIdx.x; i < 1024; i += 256) qs[i >> 7][i & 127] = q192[(long)row * 1536 + (i >> 7) * 192 + (i & 127)];
    __syncthreads();
    const int r = threadIdx.x;
    for (int h = 0; h < 8; ++h) { const float* w = w_uk + ((long)r * 8 + h) * 128; float a = 0.f; for (int n = 0; n < 128; ++n) a += qs[h][n] * w[n]; qcat[((long)row * 8 + h) * QK + r] = a; }
}
__global__ void __launch_bounds__(256) softmax_causal(float* S, float scale) {
    __shared__ float sh[4];
    const long rowi = blockIdx.x; const int s = (int)((rowi % (SEQ * 8)) >> 3); float* r = S + rowi * SEQ;
    float m = -3.0e38f; for (int k = threadIdx.x; k <= s; k += 256) m = fmaxf(m, r[k] * scale);
    for (int o = 32; o > 0; o >>= 1) m = fmaxf(m, __shfl_xor(m, o));
    __syncthreads(); if ((threadIdx.x & 63) == 0) sh[threadIdx.x >> 6] = m; __syncthreads();
    m = fmaxf(fmaxf(sh[0], sh[1]), fmaxf(sh[2], sh[3]));
    float l = 0.f; for (int k = threadIdx.x; k < SEQ; k += 256) { float e = 0.f; if (k <= s) { e = expf(r[k] * scale - m); l += e; } r[k] = e; }
    l = block_sum256(l, sh); const float inv = 1.0f / l;
    for (int k = threadIdx.x; k <= s; k += 256) r[k] *= inv;
}
__global__ void __launch_bounds__(256) dec_attn(const float* qcat, const float* kcat, const float* cache_ckv, const float* cache_kr, const int* page_table, float* olat, float scale, float* scratch) {
    __shared__ float q[QK]; __shared__ float sh[4];
    const int b = blockIdx.x >> 3, h = blockIdx.x & 7, row = NTOK + b;
    float* sc = scratch + (long)blockIdx.x * 8256;
    for (int i = threadIdx.x; i < QK; i += 256) q[i] = qcat[((long)row * 8 + h) * QK + i];
    __syncthreads();
    const int wv = threadIdx.x >> 6, lane = threadIdx.x & 63;
    for (int k = wv; k <= PAST; k += 4) {
        float a = 0.f;
        if (k < PAST) { const long pg = page_table[b * NPAGES + (k >> 7)]; const float* c = cache_ckv + (pg * PAGE + (k & 127)) * KVR; const float* kr = cache_kr + (pg * PAGE + (k & 127)) * ROPE;
            for (int i = lane; i < KVR; i += 64) a += q[i] * c[i]; a += q[256 + lane] * kr[lane]; }
        else { const float* c = kcat + (long)row * QK; for (int i = lane; i < QK; i += 64) a += q[i] * c[i]; }
        for (int o = 32; o > 0; o >>= 1) a += __shfl_xor(a, o);
        if (lane == 0) sc[k] = a * scale;
    }
    __syncthreads();
    float m = -3.0e38f; for (int k = threadIdx.x; k <= PAST; k += 256) m = fmaxf(m, sc[k]);
    for (int o = 32; o > 0; o >>= 1) m = fmaxf(m, __shfl_xor(m, o));
    __syncthreads(); if (lane == 0) sh[wv] = m; __syncthreads();
    m = fmaxf(fmaxf(sh[0], sh[1]), fmaxf(sh[2], sh[3]));
    float l = 0.f; for (int k = threadIdx.x; k <= PAST; k += 256) { const float e = expf(sc[k] - m); sc[k] = e; l += e; }
    l = block_sum256(l, sh); __syncthreads();
    const int r = threadIdx.x; float o = 0.f;
    for (int k = 0; k < PAST; ++k) { const long pg = page_table[b * NPAGES + (k >> 7)]; o += sc[k] * cache_ckv[(pg * PAGE + (k & 127)) * KVR + r]; }
    o += sc[PAST] * kcat[(long)row * QK + r];
    olat[((long)row * 8 + h) * KVR + r] = o / l;
}
__global__ void __launch_bounds__(128) uv_gate(const float* olat, const float* w_uv, const float* proj, float* mix) {
    __shared__ float os[256];
    const int row = blockIdx.x >> 3, h = blockIdx.x & 7, v = threadIdx.x;
    os[v] = olat[((long)row * 8 + h) * KVR + v]; os[v + 128] = olat[((long)row * 8 + h) * KVR + 128 + v];
    __syncthreads();
    float a = 0.f; for (int r = 0; r < 256; ++r) a += os[r] * w_uv[((long)r * 8 + h) * 128 + v];
    mix[(long)row * DMIX + h * 128 + v] = a * siluf(proj[(long)row * NPROJ + C_ZA + h * 128 + v]);
}
__global__ void __launch_bounds__(256) conv_k(const float* proj, const float* state_conv, const float* conv_w, const float* conv_b, float* xact, float* out_cp, float* out_cs) {
    const int row = blockIdx.x;
    for (int c = threadIdx.x; c < CONVD; c += 256) {
        float xp[4];
        if (row < NTOK) { const int s = row % SEQ; for (int k = 0; k < 4; ++k) { const int ss = s + k - 3; xp[k] = ss >= 0 ? proj[(long)(row + k - 3) * NPROJ + C_XBC + c] : 0.f; }
            if (s >= SEQ - 3) out_cp[((long)(row / SEQ) * 3 + (s - (SEQ - 3))) * CONVD + c] = xp[3]; }
        else { const int b = row - NTOK; for (int k = 0; k < 3; ++k) xp[k] = state_conv[((long)b * 3 + k) * CONVD + c]; xp[3] = proj[(long)row * NPROJ + C_XBC + c];
            for (int k = 0; k < 3; ++k) out_cs[((long)b * 3 + k) * CONVD + c] = xp[k + 1]; }
        float a = conv_b[c]; for (int k = 0; k < 4; ++k) a += xp[k] * conv_w[k * CONVD + c];
        xact[(long)row * CONVD + c] = siluf(a);
    }
}
__global__ void __launch_bounds__(256) ssd_rec(const float* xact, const float* proj, const float* dt_bias, const float* a_log, const float* h0, float* y, float* hout, int row0_stride, int row_base, int steps) {
    const int seq = blockIdx.x >> 4, hd = blockIdx.x & 15, g = hd >> 3, p = threadIdx.x >> 2, nb = (threadIdx.x & 3) * 32;
    float h[32];
    for (int i = 0; i < 32; ++i) h[i] = h0 ? h0[(((long)seq * 16 + hd) * 64 + p) * 128 + nb + i] : 0.f;
    const float A = -expf(a_log[hd]), dtb = dt_bias[hd];
    for (int t = 0; t < steps; ++t) {
        const long row = row_base + (long)seq * row0_stride + t;
        const float* xr = xact + row * CONVD;
        float dtr = proj[row * NPROJ + C_DT + hd] + dtb; const float dt = dtr > 20.f ? dtr : log1pf(expf(dtr));
        const float dec = expf(dt * A), xd = xr[hd * 64 + p] * dt;
        const float* Bv = xr + 1024 + g * 128 + nb; const float* Cv = xr + 1280 + g * 128 + nb;
        float acc = 0.f;
#pragma unroll
        for (int i = 0; i < 32; ++i) { h[i] = dec * h[i] + xd * Bv[i]; acc += h[i] * Cv[i]; }
        acc += __shfl_xor(acc, 1); acc += __shfl_xor(acc, 2);
        if ((threadIdx.x & 3) == 0) y[row * DSSM + hd * 64 + p] = acc;
    }
    for (int i = 0; i < 32; ++i) hout[(((long)seq * 16 + hd) * 64 + p) * 128 + nb + i] = h[i];
}
__global__ void __launch_bounds__(256) ssd_out_k(const float* y, const float* xact, const float* proj, const float* d_skip, const float* ssm_norm, float* mix) {
    __shared__ float sh[4];
    const int row = blockIdx.x >> 1, g = blockIdx.x & 1;
    float v[2]; float s = 0.f;
    for (int i = 0; i < 2; ++i) { const int c = g * 512 + threadIdx.x + i * 256; const int hd = c >> 6;
        const float yy = y[(long)row * DSSM + c] + d_skip[hd] * xact[(long)row * CONVD + c];
        v[i] = yy * siluf(proj[(long)row * NPROJ + C_ZS + c]); s += v[i] * v[i]; }
    s = block_sum256(s, sh); const float rstd = 1.0f / sqrtf(s / 512.f + EPS);
    for (int i = 0; i < 2; ++i) { const int c = g * 512 + threadIdx.x + i * 256; mix[(long)row * DMIX + 1024 + c] = v[i] * rstd * ssm_norm[c]; }
}
__global__ void __launch_bounds__(256) final_k(const float* outp, const float* xp, const float* xs, const float* norm_post, float* yp, float* ys) {
    __shared__ float sh[4];
    const int row = blockIdx.x; const float* r = outp + (long)row * D_MODEL;
    const float* x = row < NTOK ? xp + (long)row * D_MODEL : xs + (long)(row - NTOK) * D_MODEL; float* o = row < NTOK ? yp + (long)row * D_MODEL : ys + (long)(row - NTOK) * D_MODEL;
    float s = 0.f; for (int c = threadIdx.x; c < D_MODEL; c += 256) s += r[c] * r[c];
    s = block_sum256(s, sh); const float rstd = 1.0f / sqrtf(s / 1024.f + EPS);
    for (int c = threadIdx.x; c < D_MODEL; c += 256) o[c] = x[c] + r[c] * rstd * norm_post[c];
}
__global__ void copy_rows(const float* in, long ld_in, float* out, long ld_out, int ncols) {
    for (int c = threadIdx.x; c < ncols; c += blockDim.x) out[(long)blockIdx.x * ld_out + c] = in[(long)blockIdx.x * ld_in + c];
}

struct Bufs { float *H, *PROJ, *QN, *Q192, *QCAT, *KCAT, *S, *OLAT, *XACT, *Y, *MIX, *OUTP, *DSC; };
inline size_t carve(char* base, size_t& off, size_t bytes, float** p) { *p = (float*)(base + off); off += (bytes + 255) & ~(size_t)255; return off; }

inline void run(void* const* d_in, float* out, char* ws, hipStream_t st) {
    const float* x_p = (const float*)d_in[0]; const float* x_s = (const float*)d_in[1]; const float* cache_ckv = (const float*)d_in[2]; const float* cache_kr = (const float*)d_in[3];
    const float* state_conv = (const float*)d_in[4]; const float* state_ssm = (const float*)d_in[5]; const int* page_table = (const int*)d_in[6];
    const float* norm_pre = (const float*)d_in[7]; const float* w_in = (const float*)d_in[8]; const float* q_a_norm = (const float*)d_in[9]; const float* w_q_b = (const float*)d_in[10];
    const float* kv_a_norm = (const float*)d_in[11]; const float* w_uk = (const float*)d_in[12]; const float* w_uv = (const float*)d_in[13]; const float* conv_w = (const float*)d_in[14];
    const float* conv_b = (const float*)d_in[15]; const float* dt_bias = (const float*)d_in[16]; const float* a_log = (const float*)d_in[17]; const float* d_skip = (const float*)d_in[18];
    const float* ssm_norm = (const float*)d_in[19]; const float* w_out = (const float*)d_in[20]; const float* norm_post = (const float*)d_in[21];
    float* y_p = out; float* y_s = y_p + (size_t)NTOK * 1024; float* ckv_p = y_s + (size_t)DEC * 1024; float* kr_p = ckv_p + (size_t)NTOK * 256; float* conv_p = kr_p + (size_t)NTOK * 64;
    float* ssm_p = conv_p + (size_t)BATCH * 3 * CONVD; float* ckv_s = ssm_p + (size_t)BATCH * 16 * 64 * 128; float* kr_s = ckv_s + (size_t)DEC * 256; float* conv_s = kr_s + (size_t)DEC * 64;
    float* ssm_s = conv_s + (size_t)DEC * 3 * CONVD;
    Bufs B; size_t off = (size_t)1 << 30;
    carve(ws, off, (size_t)MT * 1024 * 4, &B.H); carve(ws, off, (size_t)MT * NPROJ * 4, &B.PROJ); carve(ws, off, (size_t)MT * 384 * 4, &B.QN); carve(ws, off, (size_t)MT * 1536 * 4, &B.Q192);
    carve(ws, off, (size_t)MT * 8 * QK * 4, &B.QCAT); carve(ws, off, (size_t)MT * QK * 4, &B.KCAT); carve(ws, off, (size_t)BATCH * SEQ * 8 * SEQ * 4, &B.S); carve(ws, off, (size_t)MT * 8 * KVR * 4, &B.OLAT);
    carve(ws, off, (size_t)MT * CONVD * 4, &B.XACT); carve(ws, off, (size_t)MT * DSSM * 4, &B.Y); carve(ws, off, (size_t)MT * DMIX * 4, &B.MIX); carve(ws, off, (size_t)MT * 1024 * 4, &B.OUTP);
    carve(ws, off, (size_t)DEC * 8 * 8256 * 4, &B.DSC);
    const float scale = 1.0f / sqrtf(192.f);
    rmsnorm_rows<<<NTOK, 256, 0, st>>>(x_p, 1024, norm_pre, B.H, 1024, nullptr, 0, 1024);
    rmsnorm_rows<<<DEC, 256, 0, st>>>(x_s, 1024, norm_pre, B.H + (size_t)NTOK * 1024, 1024, nullptr, 0, 1024);
    gemm_f32<false><<<dim3((NPROJ + 63) / 64, (MT + 63) / 64, 1), 256, 0, st>>>(B.H, w_in, B.PROJ, MT, NPROJ, 1024, 1024, NPROJ, NPROJ, 0, 0, 0);
    rmsnorm_rows<<<MT, 256, 0, st>>>(B.PROJ + C_QA, NPROJ, q_a_norm, B.QN, 384, nullptr, 0, 384);
    gemm_f32<false><<<dim3(1536 / 64, (MT + 63) / 64, 1), 256, 0, st>>>(B.QN, w_q_b, B.Q192, MT, 1536, 384, 384, 1536, 1536, 0, 0, 0);
    rope_q<<<MT, 256, 0, st>>>(B.Q192, B.QCAT);
    qlat_k<<<MT, 256, 0, st>>>(B.Q192, w_uk, B.QCAT);
    rmsnorm_rows<<<NTOK, 256, 0, st>>>(B.PROJ + C_CR, NPROJ, kv_a_norm, B.KCAT, QK, ckv_p, 256, 256);
    rmsnorm_rows<<<DEC, 256, 0, st>>>(B.PROJ + (size_t)NTOK * NPROJ + C_CR, NPROJ, kv_a_norm, B.KCAT + (size_t)NTOK * QK, QK, ckv_s, 256, 256);
    rope_k<<<(MT + 7) / 8, 256, 0, st>>>(B.PROJ, B.KCAT, kr_p, kr_s);
    gemm_f32<true><<<dim3(SEQ / 64, SEQ * 8 / 64, BATCH), 256, 0, st>>>(B.QCAT, B.KCAT, B.S, SEQ * 8, SEQ, QK, QK, QK, SEQ, (long)SEQ * 8 * QK, (long)SEQ * QK, (long)SEQ * 8 * SEQ);
    softmax_causal<<<BATCH * SEQ * 8, 256, 0, st>>>(B.S, scale);
    gemm_f32<false><<<dim3(KVR / 64, SEQ * 8 / 64, BATCH), 256, 0, st>>>(B.S, B.KCAT, B.OLAT, SEQ * 8, KVR, SEQ, SEQ, QK, KVR, (long)SEQ * 8 * SEQ, (long)SEQ * QK, (long)SEQ * 8 * KVR);
    dec_attn<<<DEC * 8, 256, 0, st>>>(B.QCAT, B.KCAT, cache_ckv, cache_kr, page_table, B.OLAT, scale, B.DSC);
    uv_gate<<<MT * 8, 128, 0, st>>>(B.OLAT, w_uv, B.PROJ, B.MIX);
    conv_k<<<MT, 256, 0, st>>>(B.PROJ, state_conv, conv_w, conv_b, B.XACT, conv_p, conv_s);
    ssd_rec<<<BATCH * 16, 256, 0, st>>>(B.XACT, B.PROJ, dt_bias, a_log, nullptr, B.Y, ssm_p, SEQ, 0, SEQ);
    ssd_rec<<<DEC * 16, 256, 0, st>>>(B.XACT, B.PROJ, dt_bias, a_log, state_ssm, B.Y, ssm_s, 1, NTOK, 1);
    ssd_out_k<<<MT * 2, 256, 0, st>>>(B.Y, B.XACT, B.PROJ, d_skip, ssm_norm, B.MIX);
    gemm_f32<false><<<dim3(1024 / 64, (MT + 63) / 64, 1), 256, 0, st>>>(B.MIX, w_out, B.OUTP, MT, 1024, DMIX, DMIX, 1024, 1024, 0, 0, 0);
    final_k<<<MT, 256, 0, st>>>(B.OUTP, x_p, x_s, norm_post, y_p, y_s);
}
}

extern "C" void kernel_launch(void* const* d_in, const int* in_sizes, int n_in, void* d_out, int out_size, void* d_ws, size_t ws_size, hipStream_t stream) {
    ref::run(d_in, (float*)d_out, (char*)d_ws, stream);
}
```

```cpp
#include <hip/hip_runtime.h>
#include <cstdint>
#include <cstdio>
#define GAS __attribute__((address_space(1)))
#define LAS __attribute__((address_space(3)))
#define XB_TMO      128
#define XB_XCNT(j)  (256  + 64 * (j))
#define XB_XSUB(j)  (1280 + 64 * (j))
#define XB_XGEN(j)  (2304 + 64 * (j))
#define XB_TOP      3328
#define XB_TOPGEN   3392
#define XCD_BAR_WORDS 3456
#define XB_SPIN_CAP (1u << 24)

__device__ __forceinline__ unsigned xb_ld(unsigned* p)              { return __hip_atomic_load(p, __ATOMIC_RELAXED, __HIP_MEMORY_SCOPE_AGENT); }
__device__ __forceinline__ unsigned xb_add(unsigned* p, unsigned v) { return __hip_atomic_fetch_add(p, v, __ATOMIC_RELAXED, __HIP_MEMORY_SCOPE_AGENT); }
__device__ __forceinline__ unsigned xb_xcc_id() { return (unsigned)__builtin_amdgcn_s_getreg((3 << 11) | 20) & 0xFu; }
#define XB_SPIN(cond, bar) do { unsigned _sp = 0; while (cond) { __builtin_amdgcn_s_sleep(1); \
    if ((++_sp & 255u) == 0u) { if (xb_ld(&(bar)[XB_TMO])) break; if (_sp > XB_SPIN_CAP) { atomicAdd(&(bar)[XB_TMO], 1u); break; } } } } while (0)

struct XcdBarrier {
    unsigned* bar; unsigned x;
    volatile LAS unsigned* st;
};

__device__ __forceinline__ XcdBarrier xcd_barrier_post(unsigned* bar, volatile LAS unsigned* st) {
    XcdBarrier b; b.bar = bar; b.x = xb_xcc_id(); b.st = st;
    if (threadIdx.x == 0) (void)xb_add(&bar[XB_XCNT(b.x)], 1u);
    return b;
}
__device__ __forceinline__ void xcd_barrier_complete(unsigned* bar, unsigned x, unsigned& nloc, unsigned& nx) {
    const unsigned G = gridDim.x * gridDim.y * gridDim.z;
    unsigned sum, cnt, mine, sp = 0u;
    for (;;) {
        sum = 0u; cnt = 0u; mine = 0u;
#pragma unroll
        for (unsigned j = 0; j < 16; ++j) { const unsigned c = xb_ld(&bar[XB_XCNT(j)]); sum += c; cnt += (c > 0u) ? 1u : 0u; mine = (j == x) ? c : mine; }
        if (sum == G) break;
        __builtin_amdgcn_s_sleep(1);
        if ((++sp & 255u) == 0u) { if (xb_ld(&bar[XB_TMO])) break; if (sp > XB_SPIN_CAP) { atomicAdd(&bar[XB_TMO], 1u); break; } }
    }
    nloc = mine > 0u ? mine : 1u; nx = cnt > 0u ? cnt : 1u;
}

__device__ __forceinline__ void xcd_barrier(const XcdBarrier& b) {
    asm volatile("s_waitcnt vmcnt(0)" ::: "memory");
    __syncthreads();
    if (threadIdx.x == 0) {
        unsigned* bar = b.bar;
        __builtin_amdgcn_s_waitcnt(0);
        unsigned nloc = b.st[0], nx = b.st[1];
        if (nloc == 0u) { xcd_barrier_complete(bar, b.x, nloc, nx); b.st[0] = nloc; b.st[1] = nx; }
        const unsigned old = xb_add(&bar[XB_XSUB(b.x)], 1u);
        const unsigned gen = old / nloc;
        if (old + 1u == (gen + 1u) * nloc) {
            __builtin_amdgcn_fence(__ATOMIC_RELEASE, "agent");
            asm volatile("s_waitcnt vmcnt(0)" ::: "memory");
            const unsigned og = xb_add(&bar[XB_TOP], 1u);
            const unsigned tg = og / nx;
            if (og + 1u == (tg + 1u) * nx) xb_add(&bar[XB_TOPGEN], 1u);
            else XB_SPIN(xb_ld(&bar[XB_TOPGEN]) == tg, bar);
            __builtin_amdgcn_fence(__ATOMIC_ACQUIRE, "agent");
            xb_add(&bar[XB_XGEN(b.x)], 1u);
            asm volatile("s_waitcnt vmcnt(0)" ::: "memory");
        } else {
            XB_SPIN(xb_ld(&bar[XB_XGEN(b.x)]) == gen, bar);
            __builtin_amdgcn_fence(__ATOMIC_ACQUIRE, "agent");
            asm volatile("s_waitcnt vmcnt(0)" ::: "memory");
        }
    }
    __syncthreads();
}
namespace nv {
constexpr int D_MODEL = 1024, BATCH = 8, SEQ = 2048, DEC = 128, PAST = 8192, PAGE = 128, NPAGES = 64;
constexpr int NTOK = BATCH * SEQ, MT = NTOK + DEC;
constexpr int HEADS = 8, NOPE = 128, ROPE = 64, QRANK = 384, KVR = 256, VH = 128, DATTN = 1024, DSSM = 1024, DMIX = 2048;
constexpr int SH = 16, HD = 64, NG = 2, DSTATE = 128, CONVD = 1536, NPROJ = 4304;
constexpr int C_QA = 0, C_CR = 384, C_KR = 640, C_ZA = 704, C_ZS = 1728, C_XBC = 2752, C_DT = 4288;
constexpr float EPS = 1e-6f;
constexpr int QK = KVR + ROPE;

template <bool TRANSB>
__device__ __forceinline__ void gemm_vb(int vb, int t, float* sh, const float* __restrict__ A, const float* __restrict__ B, float* __restrict__ C, int M, int N, int K,
                                        int lda, int ldb, int ldc, long sA, long sB, long sC, int gx, int gy) {
    float (*As)[65] = (float (*)[65])sh; float (*Bs)[65] = (float (*)[65])(sh + 16 * 65);
    const int bx = vb % gx, by = (vb / gx) % gy, bz = vb / (gx * gy);
    A += sA * bz; B += sB * bz; C += sC * bz;
    const int tx = t & 15, ty = t >> 4, m0 = by * 64, n0 = bx * 64;
    float acc[4][4] = {};
    for (int k0 = 0; k0 < K; k0 += 16) {
        for (int i = t; i < 1024; i += 256) { const int mm = i >> 4, kk = i & 15; const int m = m0 + mm; As[kk][mm] = (m < M) ? A[(long)m * lda + k0 + kk] : 0.f; }
        if (TRANSB) { for (int i = t; i < 1024; i += 256) { const int nn = i >> 4, kk = i & 15; const int n = n0 + nn; Bs[kk][nn] = (n < N) ? B[(long)n * ldb + k0 + kk] : 0.f; } }
        else        { for (int i = t; i < 1024; i += 256) { const int kk = i >> 6, nn = i & 63; const int n = n0 + nn; Bs[kk][nn] = (n < N) ? B[(long)(k0 + kk) * ldb + n] : 0.f; } }
        __syncthreads();
#pragma unroll
        for (int kk = 0; kk < 16; ++kk) {
            float a[4], b[4];
#pragma unroll
            for (int i = 0; i < 4; ++i) { a[i] = As[kk][ty * 4 + i]; b[i] = Bs[kk][tx * 4 + i]; }
#pragma unroll
            for (int i = 0; i < 4; ++i)
#pragma unroll
                for (int j = 0; j < 4; ++j) acc[i][j] += a[i] * b[j];
        }
        __syncthreads();
    }
#pragma unroll
    for (int i = 0; i < 4; ++i) { const int m = m0 + ty * 4 + i; if (m >= M) continue;
#pragma unroll
        for (int j = 0; j < 4; ++j) { const int n = n0 + tx * 4 + j; if (n < N) C[(long)m * ldc + n] = acc[i][j]; } }
}
__device__ __forceinline__ float block_sum256(float v, float* sh, int t) {
    for (int o = 32; o > 0; o >>= 1) v += __shfl_xor(v, o);
    __syncthreads();
    if ((t & 63) == 0) sh[t >> 6] = v;
    __syncthreads();
    return sh[0] + sh[1] + sh[2] + sh[3];
}
__device__ __forceinline__ float block_max256(float v, float* sh, int t) {
    for (int o = 32; o > 0; o >>= 1) v = fmaxf(v, __shfl_xor(v, o));
    __syncthreads();
    if ((t & 63) == 0) sh[t >> 6] = v;
    __syncthreads();
    return fmaxf(fmaxf(sh[0], sh[1]), fmaxf(sh[2], sh[3]));
}
__device__ __forceinline__ void rmsnorm_vb(int vb, int t, float* sh, const float* in, long ld_in, const float* w, float* out, long ld_out, float* out2, long ld_out2, int ncols) {
    const float* r = in + (long)vb * ld_in;
    float s = 0.f; for (int c = t; c < ncols; c += 256) { const float v = r[c]; s += v * v; }
    s = block_sum256(s, sh, t);
    const float rstd = 1.0f / sqrtf(s / (float)ncols + EPS);
    for (int c = t; c < ncols; c += 256) { const float v = r[c] * rstd * w[c]; out[(long)vb * ld_out + c] = v; if (out2) out2[(long)vb * ld_out2 + c] = v; }
}
__device__ __forceinline__ float siluf(float v) { return v / (1.0f + expf(-v)); }
__device__ __forceinline__ int tok_pos(int row) { return row < NTOK ? (row % SEQ) : PAST; }
__device__ __forceinline__ void rope_cs(int pos, int j, float& c, float& s) {
    const double inv = exp(-(double)j / 32.0 * log(10000.0)); const double a = (double)pos * inv; c = (float)cos(a); s = (float)sin(a);
}
__device__ __forceinline__ void rope_q_vb(int vb, int t, const float* q192, float* qcat) {
    const int row = vb, h = t >> 5, j = t & 31;
    float c, s; rope_cs(tok_pos(row), j, c, s);
    const float x1 = q192[(long)row * 1536 + h * 192 + 128 + j], x2 = q192[(long)row * 1536 + h * 192 + 160 + j];
    qcat[((long)row * 8 + h) * QK + 256 + j] = x1 * c - x2 * s; qcat[((long)row * 8 + h) * QK + 288 + j] = x1 * s + x2 * c;
}
__device__ __forceinline__ void rope_k_vb(int vb, int t, const float* proj, float* kcat, float* out_p, float* out_s) {
    const int row = vb * 8 + (t >> 5), j = t & 31; if (row >= MT) return;
    float c, s; rope_cs(tok_pos(row), j, c, s);
    const float x1 = proj[(long)row * NPROJ + C_KR + j], x2 = proj[(long)row * NPROJ + C_KR + 32 + j];
    const float a = x1 * c - x2 * s, b = x1 * s + x2 * c;
    kcat[(long)row * QK + 256 + j] = a; kcat[(long)row * QK + 288 + j] = b;
    float* o = row < NTOK ? out_p + (long)row * 64 : out_s + (long)(row - NTOK) * 64; o[j] = a; o[32 + j] = b;
}
__device__ __forceinline__ void qlat_vb(int vb, int t, float* sh, const float* q192, const float* w_uk, float* qcat) {
    float (*qs)[128] = (float (*)[128])sh;
    const int row = vb;
    for (int i = t; i < 1024; i += 256) qs[i >> 7][i & 127] = q192[(long)row * 1536 + (i >> 7) * 192 + (i & 127)];
    __syncthreads();
    const int r = t;
    for (int h = 0; h < 8; ++h) { const float* w = w_uk + ((long)r * 8 + h) * 128; float a = 0.f; for (int n = 0; n < 128; ++n) a += qs[h][n] * w[n]; qcat[((long)row * 8 + h) * QK + r] = a; }
}
__device__ __forceinline__ void softmax_vb(int vb, int t, float* sh, float* S, float scale) {
    const long rowi = vb; const int s = (int)((rowi % (SEQ * 8)) >> 3); float* r = S + rowi * SEQ;
    float m = -3.0e38f; for (int k = t; k <= s; k += 256) m = fmaxf(m, r[k] * scale);
    m = block_max256(m, sh, t);
    float l = 0.f; for (int k = t; k < SEQ; k += 256) { float e = 0.f; if (k <= s) { e = expf(r[k] * scale - m); l += e; } r[k] = e; }
    l = block_sum256(l, sh, t); const float inv = 1.0f / l;
    for (int k = t; k <= s; k += 256) r[k] *= inv;
}
__device__ __forceinline__ void dec_attn_vb(int vb, int t, float* sh, const float* qcat, const float* kcat, const float* cache_ckv, const float* cache_kr, const int* page_table, float* olat, float scale, float* scratch) {
    float* q = sh + 8;
    const int b = vb >> 3, h = vb & 7, row = NTOK + b;
    float* sc = scratch + (long)vb * 8256;
    __syncthreads();
    for (int i = t; i < QK; i += 256) q[i] = qcat[((long)row * 8 + h) * QK + i];
    __syncthreads();
    const int wv = t >> 6, lane = t & 63;
    for (int k = wv; k <= PAST; k += 4) {
        float a = 0.f;
        if (k < PAST) { const long pg = page_table[b * NPAGES + (k >> 7)]; const float* c = cache_ckv + (pg * PAGE + (k & 127)) * KVR; const float* kr = cache_kr + (pg * PAGE + (k & 127)) * ROPE;
            for (int i = lane; i < KVR; i += 64) a += q[i] * c[i]; a += q[256 + lane] * kr[lane]; }
        else { const float* c = kcat + (long)row * QK; for (int i = lane; i < QK; i += 64) a += q[i] * c[i]; }
        for (int o = 32; o > 0; o >>= 1) a += __shfl_xor(a, o);
        if (lane == 0) sc[k] = a * scale;
    }
    __threadfence_block(); __syncthreads();
    float m = -3.0e38f; for (int k = t; k <= PAST; k += 256) m = fmaxf(m, sc[k]);
    m = block_max256(m, sh, t);
    float l = 0.f; for (int k = t; k <= PAST; k += 256) { const float e = expf(sc[k] - m); sc[k] = e; l += e; }
    l = block_sum256(l, sh, t); __threadfence_block(); __syncthreads();
    const int r = t; float o = 0.f;
    for (int k = 0; k < PAST; ++k) { const long pg = page_table[b * NPAGES + (k >> 7)]; o += sc[k] * cache_ckv[(pg * PAGE + (k & 127)) * KVR + r]; }
    o += sc[PAST] * kcat[(long)row * QK + r];
    olat[((long)row * 8 + h) * KVR + r] = o / l;
}
__device__ __forceinline__ void uv_gate_vb(int vb, int t, float* sh, const float* olat, const float* w_uv, const float* proj, float* mix) {
    const int row = vb >> 2, h = (vb & 3) * 2 + (t >> 7), v = t & 127; float* os = sh + (t >> 7) * 256;
    __syncthreads();
    os[v] = olat[((long)row * 8 + h) * KVR + v]; os[v + 128] = olat[((long)row * 8 + h) * KVR + 128 + v];
    __syncthreads();
    float a = 0.f; for (int r = 0; r < 256; ++r) a += os[r] * w_uv[((long)r * 8 + h) * 128 + v];
    mix[(long)row * DMIX + h * 128 + v] = a * siluf(proj[(long)row * NPROJ + C_ZA + h * 128 + v]);
}
__device__ __forceinline__ void conv_vb(int vb, int t, const float* proj, const float* state_conv, const float* conv_w, const float* conv_b, float* xact, float* out_cp, float* out_cs) {
    const int row = vb;
    for (int c = t; c < CONVD; c += 256) {
        float xp[4];
        if (row < NTOK) { const int s = row % SEQ; for (int k = 0; k < 4; ++k) { const int ss = s + k - 3; xp[k] = ss >= 0 ? proj[(long)(row + k - 3) * NPROJ + C_XBC + c] : 0.f; }
            if (s >= SEQ - 3) out_cp[((long)(row / SEQ) * 3 + (s - (SEQ - 3))) * CONVD + c] = xp[3]; }
        else { const int b = row - NTOK; for (int k = 0; k < 3; ++k) xp[k] = state_conv[((long)b * 3 + k) * CONVD + c]; xp[3] = proj[(long)row * NPROJ + C_XBC + c];
            for (int k = 0; k < 3; ++k) out_cs[((long)b * 3 + k) * CONVD + c] = xp[k + 1]; }
        float a = conv_b[c]; for (int k = 0; k < 4; ++k) a += xp[k] * conv_w[k * CONVD + c];
        xact[(long)row * CONVD + c] = siluf(a);
    }
}
__device__ __forceinline__ void ssd_rec_vb(int vb, int t, const float* xact, const float* proj, const float* dt_bias, const float* a_log, const float* h0, float* y, float* hout, int row0_stride, int row_base, int steps) {
    const int seq = vb >> 4, hd = vb & 15, g = hd >> 3, p = t >> 2, nb = (t & 3) * 32;
    float h[32];
    for (int i = 0; i < 32; ++i) h[i] = h0 ? h0[(((long)seq * 16 + hd) * 64 + p) * 128 + nb + i] : 0.f;
    const float A = -expf(a_log[hd]), dtb = dt_bias[hd];
    for (int tt = 0; tt < steps; ++tt) {
        const long row = row_base + (long)seq * row0_stride + tt;
        const float* xr = xact + row * CONVD;
        float dtr = proj[row * NPROJ + C_DT + hd] + dtb; const float dt = dtr > 20.f ? dtr : log1pf(expf(dtr));
        const float dec = expf(dt * A), xd = xr[hd * 64 + p] * dt;
        const float* Bv = xr + 1024 + g * 128 + nb; const float* Cv = xr + 1280 + g * 128 + nb;
        float acc = 0.f;
#pragma unroll
        for (int i = 0; i < 32; ++i) { h[i] = dec * h[i] + xd * Bv[i]; acc += h[i] * Cv[i]; }
        acc += __shfl_xor(acc, 1); acc += __shfl_xor(acc, 2);
        if ((t & 3) == 0) y[row * DSSM + hd * 64 + p] = acc;
    }
    for (int i = 0; i < 32; ++i) hout[(((long)seq * 16 + hd) * 64 + p) * 128 + nb + i] = h[i];
}
__device__ __forceinline__ void ssd_out_vb(int vb, int t, float* sh, const float* y, const float* xact, const float* proj, const float* d_skip, const float* ssm_norm, float* mix) {
    const int row = vb >> 1, g = vb & 1;
    float v[2]; float s = 0.f;
    for (int i = 0; i < 2; ++i) { const int c = g * 512 + t + i * 256; const int hd = c >> 6;
        const float yy = y[(long)row * DSSM + c] + d_skip[hd] * xact[(long)row * CONVD + c];
        v[i] = yy * siluf(proj[(long)row * NPROJ + C_ZS + c]); s += v[i] * v[i]; }
    s = block_sum256(s, sh, t); const float rstd = 1.0f / sqrtf(s / 512.f + EPS);
    for (int i = 0; i < 2; ++i) { const int c = g * 512 + t + i * 256; mix[(long)row * DMIX + 1024 + c] = v[i] * rstd * ssm_norm[c]; }
}
__device__ __forceinline__ void final_vb(int vb, int t, float* sh, const float* outp, const float* xp, const float* xs, const float* norm_post, float* yp, float* ys) {
    const int row = vb; const float* r = outp + (long)row * D_MODEL;
    const float* x = row < NTOK ? xp + (long)row * D_MODEL : xs + (long)(row - NTOK) * D_MODEL; float* o = row < NTOK ? yp + (long)row * D_MODEL : ys + (long)(row - NTOK) * D_MODEL;
    float s = 0.f; for (int c = t; c < D_MODEL; c += 256) s += r[c] * r[c];
    s = block_sum256(s, sh, t); const float rstd = 1.0f / sqrtf(s / 1024.f + EPS);
    for (int c = t; c < D_MODEL; c += 256) o[c] = x[c] + r[c] * rstd * norm_post[c];
}
struct Bufs { float *H, *PROJ, *QN, *Q192, *QCAT, *KCAT, *S, *OLAT, *XACT, *Y, *MIX, *OUTP, *DSC; };
__host__ __device__ inline void carve(unsigned char* base, size_t& off, size_t bytes, float** p) { *p = (float*)(base + off); off += (bytes + 255) & ~(size_t)255; }
__host__ __device__ inline void make_bufs(unsigned char* ws, Bufs& B) {
    size_t off = (size_t)1 << 30;
    carve(ws, off, (size_t)MT * 1024 * 4, &B.H); carve(ws, off, (size_t)MT * NPROJ * 4, &B.PROJ); carve(ws, off, (size_t)MT * 384 * 4, &B.QN); carve(ws, off, (size_t)MT * 1536 * 4, &B.Q192);
    carve(ws, off, (size_t)MT * 8 * QK * 4, &B.QCAT); carve(ws, off, (size_t)MT * QK * 4, &B.KCAT); carve(ws, off, (size_t)BATCH * SEQ * 8 * SEQ * 4, &B.S); carve(ws, off, (size_t)MT * 8 * KVR * 4, &B.OLAT);
    carve(ws, off, (size_t)MT * CONVD * 4, &B.XACT); carve(ws, off, (size_t)MT * DSSM * 4, &B.Y); carve(ws, off, (size_t)MT * DMIX * 4, &B.MIX); carve(ws, off, (size_t)MT * 1024 * 4, &B.OUTP);
    carve(ws, off, (size_t)DEC * 8 * 8256 * 4, &B.DSC);
}
}
constexpr int NWAVES = 8;
constexpr int LDS_BYTES = 147456;
constexpr int LDSCTL_OFF = 131072, MISC_OFF = LDSCTL_OFF + 320;
constexpr size_t WS_CTL = 0, CTL_ZERO_BYTES = 1u << 20;
constexpr int CW_BAR = 4096;
struct Args { const void* in[22]; float* out; unsigned char* ws; int ph_lo, ph_hi; };

__global__ void __launch_bounds__(NWAVES * 64, 2) mega_fwd(Args args) {
    extern __shared__ __attribute__((aligned(16))) unsigned char lds[];
    LAS unsigned char* L = (LAS unsigned char*)lds;
    for (int u = threadIdx.x; u < (LDS_BYTES - LDSCTL_OFF) / 4; u += NWAVES * 64) ((LAS unsigned*)(L + LDSCTL_OFF))[u] = 0u;
    __syncthreads();
    unsigned* ctl = (unsigned*)(args.ws + WS_CTL);
    XcdBarrier bar = xcd_barrier_post(ctl + CW_BAR, (volatile LAS unsigned*)(L + MISC_OFF) + 8);
    const int lo = args.ph_lo, hi = args.ph_hi;
#define IN(k) (lo <= (k) && (k) < hi)
#define SEAM(k) do { if (IN(k) && IN((k) + 1)) xcd_barrier(bar); } while (0)
    using namespace nv;
    const float* x_p = (const float*)args.in[0]; const float* x_s = (const float*)args.in[1]; const float* cache_ckv = (const float*)args.in[2]; const float* cache_kr = (const float*)args.in[3];
    const float* state_conv = (const float*)args.in[4]; const float* state_ssm = (const float*)args.in[5]; const int* page_table = (const int*)args.in[6];
    const float* norm_pre = (const float*)args.in[7]; const float* w_in = (const float*)args.in[8]; const float* q_a_norm = (const float*)args.in[9]; const float* w_q_b = (const float*)args.in[10];
    const float* kv_a_norm = (const float*)args.in[11]; const float* w_uk = (const float*)args.in[12]; const float* w_uv = (const float*)args.in[13]; const float* conv_w = (const float*)args.in[14];
    const float* conv_b = (const float*)args.in[15]; const float* dt_bias = (const float*)args.in[16]; const float* a_log = (const float*)args.in[17]; const float* d_skip = (const float*)args.in[18];
    const float* ssm_norm = (const float*)args.in[19]; const float* w_out = (const float*)args.in[20]; const float* norm_post = (const float*)args.in[21];
    float* out = args.out;
    float* y_p = out; float* y_s = y_p + (size_t)NTOK * 1024; float* ckv_p = y_s + (size_t)DEC * 1024; float* kr_p = ckv_p + (size_t)NTOK * 256; float* conv_p = kr_p + (size_t)NTOK * 64;
    float* ssm_p = conv_p + (size_t)BATCH * 3 * CONVD; float* ckv_s = ssm_p + (size_t)BATCH * 16 * 64 * 128; float* kr_s = ckv_s + (size_t)DEC * 256; float* conv_s = kr_s + (size_t)DEC * 64;
    float* ssm_s = conv_s + (size_t)DEC * 3 * CONVD;
    Bufs B; make_bufs(args.ws, B);
    const int half = threadIdx.x >> 8, t = threadIdx.x & 255;
    float* sh = (float*)lds + half * 4096;
    const float scale = 1.0f / sqrtf(192.f);
#define VBLOOP(nvb) for (int vb0 = blockIdx.x * 2, vb = vb0 + half; vb0 < (nvb); vb0 += gridDim.x * 2, vb = vb0 + half, __syncthreads())
    if (IN(0)) { VBLOOP(MT) { if (vb < NTOK) rmsnorm_vb(vb, t, sh, x_p, 1024, norm_pre, B.H, 1024, nullptr, 0, 1024); else rmsnorm_vb(vb - NTOK, t, sh, x_s, 1024, norm_pre, B.H + (size_t)NTOK * 1024, 1024, nullptr, 0, 1024); } }
    SEAM(0);
    if (IN(1)) { VBLOOP(68 * 258) gemm_vb<false>(vb, t, sh, B.H, w_in, B.PROJ, MT, NPROJ, 1024, 1024, NPROJ, NPROJ, 0, 0, 0, 68, 258); }
    SEAM(1);
    if (IN(2)) {
        VBLOOP(MT) rmsnorm_vb(vb, t, sh, B.PROJ + C_QA, NPROJ, q_a_norm, B.QN, 384, nullptr, 0, 384);
        VBLOOP(MT) { if (vb < NTOK) rmsnorm_vb(vb, t, sh, B.PROJ + C_CR, NPROJ, kv_a_norm, B.KCAT, QK, ckv_p, 256, 256);
                     else rmsnorm_vb(vb - NTOK, t, sh, B.PROJ + (size_t)NTOK * NPROJ + C_CR, NPROJ, kv_a_norm, B.KCAT + (size_t)NTOK * QK, QK, ckv_s, 256, 256); }
        VBLOOP(2064) rope_k_vb(vb, t, B.PROJ, B.KCAT, kr_p, kr_s);
        VBLOOP(MT) conv_vb(vb, t, B.PROJ, state_conv, conv_w, conv_b, B.XACT, conv_p, conv_s);
    }
    SEAM(2);
    if (IN(3)) { VBLOOP(24 * 258) gemm_vb<false>(vb, t, sh, B.QN, w_q_b, B.Q192, MT, 1536, 384, 384, 1536, 1536, 0, 0, 0, 24, 258); }
    SEAM(3);
    if (IN(4)) { VBLOOP(MT) rope_q_vb(vb, t, B.Q192, B.QCAT); VBLOOP(MT) qlat_vb(vb, t, sh, B.Q192, w_uk, B.QCAT); }
    SEAM(4);
    if (IN(5)) {
        VBLOOP(BATCH * 16) ssd_rec_vb(vb, t, B.XACT, B.PROJ, dt_bias, a_log, nullptr, B.Y, ssm_p, SEQ, 0, SEQ);
        VBLOOP(32 * 256 * 8) gemm_vb<true>(vb, t, sh, B.QCAT, B.KCAT, B.S, SEQ * 8, SEQ, QK, QK, QK, SEQ, (long)SEQ * 8 * QK, (long)SEQ * QK, (long)SEQ * 8 * SEQ, 32, 256);
        VBLOOP(DEC * 8) dec_attn_vb(vb, t, sh, B.QCAT, B.KCAT, cache_ckv, cache_kr, page_table, B.OLAT, scale, B.DSC);
        VBLOOP(DEC * 16) ssd_rec_vb(vb, t, B.XACT, B.PROJ, dt_bias, a_log, state_ssm, B.Y, ssm_s, 1, NTOK, 1);
    }
    SEAM(5);
    if (IN(6)) { VBLOOP(BATCH * SEQ * 8) softmax_vb(vb, t, sh, B.S, scale); VBLOOP(MT * 2) ssd_out_vb(vb, t, sh, B.Y, B.XACT, B.PROJ, d_skip, ssm_norm, B.MIX); }
    SEAM(6);
    if (IN(7)) { VBLOOP(4 * 256 * 8) gemm_vb<false>(vb, t, sh, B.S, B.KCAT, B.OLAT, SEQ * 8, KVR, SEQ, SEQ, QK, KVR, (long)SEQ * 8 * SEQ, (long)SEQ * QK, (long)SEQ * 8 * KVR, 4, 256); }
    SEAM(7);
    if (IN(8)) { VBLOOP(MT * 4) uv_gate_vb(vb, t, sh, B.OLAT, w_uv, B.PROJ, B.MIX); }
    SEAM(8);
    if (IN(9)) { VBLOOP(16 * 258) gemm_vb<false>(vb, t, sh, B.MIX, w_out, B.OUTP, MT, 1024, DMIX, DMIX, 1024, 1024, 0, 0, 0, 16, 258); }
    SEAM(9);
    if (IN(10)) { VBLOOP(MT) final_vb(vb, t, sh, B.OUTP, x_p, x_s, norm_post, y_p, y_s); }
#undef IN
#undef SEAM
}
constexpr int N_PHASES = 11;
#ifndef MK_PER_PHASE
#define MK_PER_PHASE 0
#endif
extern "C" void kernel_launch(void* const* d_in, const int* in_sizes, int n_in, void* d_out, int out_size, void* d_ws, size_t ws_size, hipStream_t stream) {
    static int grid = 0;
    if (grid == 0) {
        int dev = 0, cus = 0;
        if (hipGetDevice(&dev) != hipSuccess || hipDeviceGetAttribute(&cus, hipDeviceAttributeMultiprocessorCount, dev) != hipSuccess) { grid = -1; return; }
        if (hipFuncSetAttribute((const void*)mega_fwd, hipFuncAttributeMaxDynamicSharedMemorySize, LDS_BYTES) != hipSuccess) { fprintf(stderr, "kernel_launch: hipFuncSetAttribute failed\n"); grid = -1; return; }
        int per_cu = 0;
        if (hipOccupancyMaxActiveBlocksPerMultiprocessor(&per_cu, (const void*)mega_fwd, NWAVES * 64, LDS_BYTES) != hipSuccess || per_cu < 1) fprintf(stderr, "kernel_launch: occupancy query says %d\n", per_cu);
        (void)hipGetLastError();
        grid = cus;
    }
    if (grid < 0) return;
    (void)hipMemsetAsync((char*)d_ws + WS_CTL, 0, CTL_ZERO_BYTES, stream);
    Args a{};
    for (int i = 0; i < 22; ++i) a.in[i] = d_in[i];
    a.out = (float*)d_out; a.ws = (unsigned char*)d_ws;
#if MK_PER_PHASE
    for (int p = 0; p < N_PHASES; ++p) { a.ph_lo = p; a.ph_hi = p + 1; hipLaunchKernelGGL(mega_fwd, dim3(grid), dim3(NWAVES * 64), LDS_BYTES, stream, a); }
#else
    a.ph_lo = 0; a.ph_hi = N_PHASES;
    hipLaunchKernelGGL(mega_fwd, dim3(grid), dim3(NWAVES * 64), LDS_BYTES, stream, a);
#endif
}
```

```cpp
#include <hip/hip_runtime.h>
#include <cstdint>
#include <cstdio>
#define GAS __attribute__((address_space(1)))
#define LAS __attribute__((address_space(3)))
#define XB_TMO      128
#define XB_XCNT(j)  (256  + 64 * (j))
#define XB_XSUB(j)  (1280 + 64 * (j))
#define XB_XGEN(j)  (2304 + 64 * (j))
#define XB_TOP      3328
#define XB_TOPGEN   3392
#define XCD_BAR_WORDS 3456
#define XB_SPIN_CAP (1u << 24)

__device__ __forceinline__ unsigned xb_ld(unsigned* p)              { return __hip_atomic_load(p, __ATOMIC_RELAXED, __HIP_MEMORY_SCOPE_AGENT); }
__device__ __forceinline__ unsigned xb_add(unsigned* p, unsigned v) { return __hip_atomic_fetch_add(p, v, __ATOMIC_RELAXED, __HIP_MEMORY_SCOPE_AGENT); }
__device__ __forceinline__ unsigned xb_lane() { unsigned l_; asm volatile("v_mbcnt_lo_u32_b32 %0, -1, 0\n\tv_mbcnt_hi_u32_b32 %0, -1, %0" : "=v"(l_)); return l_; }
__device__ __forceinline__ unsigned xb_xcc_id() { return (unsigned)__builtin_amdgcn_s_getreg((3 << 11) | 20) & 0xFu; }
#define XB_SPIN(cond, bar) do { unsigned _sp = 0; while (cond) { __builtin_amdgcn_s_sleep(1); \
    if ((++_sp & 255u) == 0u) { if (xb_ld(&(bar)[XB_TMO])) break; if (_sp > XB_SPIN_CAP) { atomicAdd(&(bar)[XB_TMO], 1u); break; } } } } while (0)

struct XcdBarrier {
    unsigned* bar; unsigned x; unsigned w0;
    volatile LAS unsigned* st;
};

__device__ __forceinline__ XcdBarrier xcd_barrier_post(unsigned* bar, volatile LAS unsigned* st) {
    XcdBarrier b; b.bar = bar; b.x = xb_xcc_id(); b.st = st; b.w0 = (unsigned)(__builtin_amdgcn_readfirstlane(threadIdx.x >> 6) == 0);
    if (threadIdx.x == 0) (void)xb_add(&bar[XB_XCNT(b.x)], 1u);
    return b;
}
__device__ __forceinline__ void xcd_barrier_complete(unsigned* bar, unsigned x, unsigned& nloc, unsigned& nx) {
    const unsigned G = gridDim.x * gridDim.y * gridDim.z;
    unsigned sum, cnt, mine, sp = 0u;
    for (;;) {
        sum = 0u; cnt = 0u; mine = 0u;
#pragma unroll
        for (unsigned j = 0; j < 16; ++j) { const unsigned c = xb_ld(&bar[XB_XCNT(j)]); sum += c; cnt += (c > 0u) ? 1u : 0u; mine = (j == x) ? c : mine; }
        if (sum == G) break;
        __builtin_amdgcn_s_sleep(1);
        if ((++sp & 255u) == 0u) { if (xb_ld(&bar[XB_TMO])) break; if (sp > XB_SPIN_CAP) { atomicAdd(&bar[XB_TMO], 1u); break; } }
    }
    nloc = mine > 0u ? mine : 1u; nx = cnt > 0u ? cnt : 1u;
}

__device__ __forceinline__ void xcd_barrier(const XcdBarrier& b) {
    asm volatile("s_waitcnt vmcnt(0)" ::: "memory");
    __syncthreads();
    if (b.w0 && xb_lane() == 0u) {
        unsigned* bar = b.bar;
        __builtin_amdgcn_s_waitcnt(0);
        unsigned nloc = b.st[0], nx = b.st[1];
        if (nloc == 0u) { xcd_barrier_complete(bar, b.x, nloc, nx); b.st[0] = nloc; b.st[1] = nx; }
        const unsigned old = xb_add(&bar[XB_XSUB(b.x)], 1u);
        const unsigned gen = old / nloc;
        if (old + 1u == (gen + 1u) * nloc) {
            __builtin_amdgcn_fence(__ATOMIC_RELEASE, "agent");
            asm volatile("s_waitcnt vmcnt(0)" ::: "memory");
            const unsigned og = xb_add(&bar[XB_TOP], 1u);
            const unsigned tg = og / nx;
            if (og + 1u == (tg + 1u) * nx) xb_add(&bar[XB_TOPGEN], 1u);
            else XB_SPIN(xb_ld(&bar[XB_TOPGEN]) == tg, bar);
            __builtin_amdgcn_fence(__ATOMIC_ACQUIRE, "agent");
            xb_add(&bar[XB_XGEN(b.x)], 1u);
            asm volatile("s_waitcnt vmcnt(0)" ::: "memory");
        } else {
            XB_SPIN(xb_ld(&bar[XB_XGEN(b.x)]) == gen, bar);
            __builtin_amdgcn_fence(__ATOMIC_ACQUIRE, "agent");
            asm volatile("s_waitcnt vmcnt(0)" ::: "memory");
        }
    }
    __syncthreads();
}
namespace nv {
constexpr int D_MODEL = 1024, BATCH = 8, SEQ = 2048, DEC = 128, PAST = 8192, PAGE = 128, NPAGES = 64;
constexpr int NTOK = BATCH * SEQ, MT = NTOK + DEC;
constexpr int HEADS = 8, NOPE = 128, ROPE = 64, QRANK = 384, KVR = 256, VH = 128, DATTN = 1024, DSSM = 1024, DMIX = 2048;
constexpr int SH = 16, HD = 64, NG = 2, DSTATE = 128, CONVD = 1536, NPROJ = 4304;
constexpr int C_QA = 0, C_CR = 384, C_KR = 640, C_ZA = 704, C_ZS = 1728, C_XBC = 2752, C_DT = 4288;
constexpr float EPS = 1e-6f;
constexpr int QK = KVR + ROPE;

template <bool TRANSB>
__device__ __forceinline__ void gemm_vb(int vb, int t, float* sh, const float* __restrict__ A, const float* __restrict__ B, float* __restrict__ C, int M, int N, int K,
                                        int lda, int ldb, int ldc, long sA, long sB, long sC, int gx, int gy) {
    float (*As)[65] = (float (*)[65])sh; float (*Bs)[65] = (float (*)[65])(sh + 16 * 65);
    const int bx = vb % gx, by = (vb / gx) % gy, bz = vb / (gx * gy);
    A += sA * bz; B += sB * bz; C += sC * bz;
    const int tx = t & 15, ty = t >> 4, m0 = by * 64, n0 = bx * 64;
    float acc[4][4] = {};
    for (int k0 = 0; k0 < K; k0 += 16) {
        for (int i = t; i < 1024; i += 256) { const int mm = i >> 4, kk = i & 15; const int m = m0 + mm; As[kk][mm] = (m < M) ? A[(long)m * lda + k0 + kk] : 0.f; }
        if (TRANSB) { for (int i = t; i < 1024; i += 256) { const int nn = i >> 4, kk = i & 15; const int n = n0 + nn; Bs[kk][nn] = (n < N) ? B[(long)n * ldb + k0 + kk] : 0.f; } }
        else        { for (int i = t; i < 1024; i += 256) { const int kk = i >> 6, nn = i & 63; const int n = n0 + nn; Bs[kk][nn] = (n < N) ? B[(long)(k0 + kk) * ldb + n] : 0.f; } }
        __syncthreads();
#pragma unroll
        for (int kk = 0; kk < 16; ++kk) {
            float a[4], b[4];
#pragma unroll
            for (int i = 0; i < 4; ++i) { a[i] = As[kk][ty * 4 + i]; b[i] = Bs[kk][tx * 4 + i]; }
#pragma unroll
            for (int i = 0; i < 4; ++i)
#pragma unroll
                for (int j = 0; j < 4; ++j) acc[i][j] += a[i] * b[j];
        }
        __syncthreads();
    }
#pragma unroll
    for (int i = 0; i < 4; ++i) { const int m = m0 + ty * 4 + i; if (m >= M) continue;
#pragma unroll
        for (int j = 0; j < 4; ++j) { const int n = n0 + tx * 4 + j; if (n < N) C[(long)m * ldc + n] = acc[i][j]; } }
}
__device__ __forceinline__ float block_sum256(float v, float* sh, int t) {
    for (int o = 32; o > 0; o >>= 1) v += __shfl_xor(v, o);
    __syncthreads();
    if ((t & 63) == 0) sh[t >> 6] = v;
    __syncthreads();
    return sh[0] + sh[1] + sh[2] + sh[3];
}
__device__ __forceinline__ float block_max256(float v, float* sh, int t) {
    for (int o = 32; o > 0; o >>= 1) v = fmaxf(v, __shfl_xor(v, o));
    __syncthreads();
    if ((t & 63) == 0) sh[t >> 6] = v;
    __syncthreads();
    return fmaxf(fmaxf(sh[0], sh[1]), fmaxf(sh[2], sh[3]));
}
__device__ __forceinline__ void rmsnorm_vb(int vb, int t, float* sh, const float* in, long ld_in, const float* w, float* out, long ld_out, float* out2, long ld_out2, int ncols) {
    const float* r = in + (long)vb * ld_in;
    float s = 0.f; for (int c = t; c < ncols; c += 256) { const float v = r[c]; s += v * v; }
    s = block_sum256(s, sh, t);
    const float rstd = 1.0f / sqrtf(s / (float)ncols + EPS);
    for (int c = t; c < ncols; c += 256) { const float v = r[c] * rstd * w[c]; out[(long)vb * ld_out + c] = v; if (out2) out2[(long)vb * ld_out2 + c] = v; }
}
__device__ __forceinline__ float siluf(float v) { return v / (1.0f + expf(-v)); }
__device__ __forceinline__ int tok_pos(int row) { return row < NTOK ? (row % SEQ) : PAST; }
__device__ __forceinline__ void rope_cs(int pos, int j, float& c, float& s) {
    const double inv = exp(-(double)j / 32.0 * log(10000.0)); const double a = (double)pos * inv; c = (float)cos(a); s = (float)sin(a);
}
__device__ __forceinline__ void rope_q_vb(int vb, int t, const float* q192, float* qcat) {
    const int row = vb, h = t >> 5, j = t & 31;
    float c, s; rope_cs(tok_pos(row), j, c, s);
    const float x1 = q192[(long)row * 1536 + h * 192 + 128 + j], x2 = q192[(long)row * 1536 + h * 192 + 160 + j];
    qcat[((long)row * 8 + h) * QK + 256 + j] = x1 * c - x2 * s; qcat[((long)row * 8 + h) * QK + 288 + j] = x1 * s + x2 * c;
}
__device__ __forceinline__ void rope_k_vb(int vb, int t, const float* proj, float* kcat, float* out_p, float* out_s) {
    const int row = vb * 8 + (t >> 5), j = t & 31; if (row >= MT) return;
    float c, s; rope_cs(tok_pos(row), j, c, s);
    const float x1 = proj[(long)row * NPROJ + C_KR + j], x2 = proj[(long)row * NPROJ + C_KR + 32 + j];
    const float a = x1 * c - x2 * s, b = x1 * s + x2 * c;
    kcat[(long)row * QK + 256 + j] = a; kcat[(long)row * QK + 288 + j] = b;
    float* o = row < NTOK ? out_p + (long)row * 64 : out_s + (long)(row - NTOK) * 64; o[j] = a; o[32 + j] = b;
}
__device__ __forceinline__ void qlat_vb(int vb, int t, float* sh, const float* q192, const float* w_uk, float* qcat) {
    float (*qs)[128] = (float (*)[128])sh;
    const int row = vb;
    for (int i = t; i < 1024; i += 256) qs[i >> 7][i & 127] = q192[(long)row * 1536 + (i >> 7) * 192 + (i & 127)];
    __syncthreads();
    const int r = t;
    for (int h = 0; h < 8; ++h) { const float* w = w_uk + ((long)r * 8 + h) * 128; float a = 0.f; for (int n = 0; n < 128; ++n) a += qs[h][n] * w[n]; qcat[((long)row * 8 + h) * QK + r] = a; }
}
__device__ __forceinline__ void softmax_vb(int vb, int t, float* sh, float* S, float scale) {
    const long rowi = vb; const int s = (int)((rowi % (SEQ * 8)) >> 3); float* r = S + rowi * SEQ;
    float m = -3.0e38f; for (int k = t; k <= s; k += 256) m = fmaxf(m, r[k] * scale);
    m = block_max256(m, sh, t);
    float l = 0.f; for (int k = t; k < SEQ; k += 256) { float e = 0.f; if (k <= s) { e = expf(r[k] * scale - m); l += e; } r[k] = e; }
    l = block_sum256(l, sh, t); const float inv = 1.0f / l;
    for (int k = t; k <= s; k += 256) r[k] *= inv;
}
__device__ __forceinline__ void dec_attn_vb(int vb, int t, float* sh, const float* qcat, const float* kcat, const float* cache_ckv, const float* cache_kr, const int* page_table, float* olat, float scale, float* scratch) {
    float* q = sh + 8;
    const int b = vb >> 3, h = vb & 7, row = NTOK + b;
    float* sc = scratch + (long)vb * 8256;
    __syncthreads();
    for (int i = t; i < QK; i += 256) q[i] = qcat[((long)row * 8 + h) * QK + i];
    __syncthreads();
    const int wv = t >> 6, lane = t & 63;
    for (int k = wv; k <= PAST; k += 4) {
        float a = 0.f;
        if (k < PAST) { const long pg = page_table[b * NPAGES + (k >> 7)]; const float* c = cache_ckv + (pg * PAGE + (k & 127)) * KVR; const float* kr = cache_kr + (pg * PAGE + (k & 127)) * ROPE;
            for (int i = lane; i < KVR; i += 64) a += q[i] * c[i]; a += q[256 + lane] * kr[lane]; }
        else { const float* c = kcat + (long)row * QK; for (int i = lane; i < QK; i += 64) a += q[i] * c[i]; }
        for (int o = 32; o > 0; o >>= 1) a += __shfl_xor(a, o);
        if (lane == 0) sc[k] = a * scale;
    }
    __threadfence_block(); __syncthreads();
    float m = -3.0e38f; for (int k = t; k <= PAST; k += 256) m = fmaxf(m, sc[k]);
    m = block_max256(m, sh, t);
    float l = 0.f; for (int k = t; k <= PAST; k += 256) { const float e = expf(sc[k] - m); sc[k] = e; l += e; }
    l = block_sum256(l, sh, t); __threadfence_block(); __syncthreads();
    const int r = t; float o = 0.f;
    for (int k = 0; k < PAST; ++k) { const long pg = page_table[b * NPAGES + (k >> 7)]; o += sc[k] * cache_ckv[(pg * PAGE + (k & 127)) * KVR + r]; }
    o += sc[PAST] * kcat[(long)row * QK + r];
    olat[((long)row * 8 + h) * KVR + r] = o / l;
}
__device__ __forceinline__ void uv_gate_vb(int vb, int t, float* sh, const float* olat, const float* w_uv, const float* proj, float* mix) {
    const int row = vb >> 2, h = (vb & 3) * 2 + (t >> 7), v = t & 127; float* os = sh + (t >> 7) * 256;
    __syncthreads();
    os[v] = olat[((long)row * 8 + h) * KVR + v]; os[v + 128] = olat[((long)row * 8 + h) * KVR + 128 + v];
    __syncthreads();
    float a = 0.f; for (int r = 0; r < 256; ++r) a += os[r] * w_uv[((long)r * 8 + h) * 128 + v];
    mix[(long)row * DMIX + h * 128 + v] = a * siluf(proj[(long)row * NPROJ + C_ZA + h * 128 + v]);
}
__device__ __forceinline__ void conv_vb(int vb, int t, const float* proj, const float* state_conv, const float* conv_w, const float* conv_b, float* xact, float* out_cp, float* out_cs) {
    const int row = vb;
    for (int c = t; c < CONVD; c += 256) {
        float xp[4];
        if (row < NTOK) { const int s = row % SEQ; for (int k = 0; k < 4; ++k) { const int ss = s + k - 3; xp[k] = ss >= 0 ? proj[(long)(row + k - 3) * NPROJ + C_XBC + c] : 0.f; }
            if (s >= SEQ - 3) out_cp[((long)(row / SEQ) * 3 + (s - (SEQ - 3))) * CONVD + c] = xp[3]; }
        else { const int b = row - NTOK; for (int k = 0; k < 3; ++k) xp[k] = state_conv[((long)b * 3 + k) * CONVD + c]; xp[3] = proj[(long)row * NPROJ + C_XBC + c];
            for (int k = 0; k < 3; ++k) out_cs[((long)b * 3 + k) * CONVD + c] = xp[k + 1]; }
        float a = conv_b[c]; for (int k = 0; k < 4; ++k) a += xp[k] * conv_w[k * CONVD + c];
        xact[(long)row * CONVD + c] = siluf(a);
    }
}
__device__ __forceinline__ void ssd_rec_vb(int vb, int t, const float* xact, const float* proj, const float* dt_bias, const float* a_log, const float* h0, float* y, float* hout, int row0_stride, int row_base, int steps) {
    const int seq = vb >> 4, hd = vb & 15, g = hd >> 3, p = t >> 2, nb = (t & 3) * 32;
    float h[32];
    for (int i = 0; i < 32; ++i) h[i] = h0 ? h0[(((long)seq * 16 + hd) * 64 + p) * 128 + nb + i] : 0.f;
    const float A = -expf(a_log[hd]), dtb = dt_bias[hd];
    for (int tt = 0; tt < steps; ++tt) {
        const long row = row_base + (long)seq * row0_stride + tt;
        const float* xr = xact + row * CONVD;
        float dtr = proj[row * NPROJ + C_DT + hd] + dtb; const float dt = dtr > 20.f ? dtr : log1pf(expf(dtr));
        const float dec = expf(dt * A), xd = xr[hd * 64 + p] * dt;
        const float* Bv = xr + 1024 + g * 128 + nb; const float* Cv = xr + 1280 + g * 128 + nb;
        float acc = 0.f;
#pragma unroll
        for (int i = 0; i < 32; ++i) { h[i] = dec * h[i] + xd * Bv[i]; acc += h[i] * Cv[i]; }
        acc += __shfl_xor(acc, 1); acc += __shfl_xor(acc, 2);
        if ((t & 3) == 0) y[row * DSSM + hd * 64 + p] = acc;
    }
    for (int i = 0; i < 32; ++i) hout[(((long)seq * 16 + hd) * 64 + p) * 128 + nb + i] = h[i];
}
__device__ __forceinline__ void ssd_out_vb(int vb, int t, float* sh, const float* y, const float* xact, const float* proj, const float* d_skip, const float* ssm_norm, float* mix) {
    const int row = vb >> 1, g = vb & 1;
    float v[2]; float s = 0.f;
    for (int i = 0; i < 2; ++i) { const int c = g * 512 + t + i * 256; const int hd = c >> 6;
        const float yy = y[(long)row * DSSM + c] + d_skip[hd] * xact[(long)row * CONVD + c];
        v[i] = yy * siluf(proj[(long)row * NPROJ + C_ZS + c]); s += v[i] * v[i]; }
    s = block_sum256(s, sh, t); const float rstd = 1.0f / sqrtf(s / 512.f + EPS);
    for (int i = 0; i < 2; ++i) { const int c = g * 512 + t + i * 256; mix[(long)row * DMIX + 1024 + c] = v[i] * rstd * (ssm_norm ? ssm_norm[c] : 1.f); }
}
__device__ __forceinline__ void final_vb(int vb, int t, float* sh, const float* outp, const float* xp, const float* xs, const float* norm_post, float* yp, float* ys) {
    const int row = vb; const float* r = outp + (long)row * D_MODEL;
    const float* x = row < NTOK ? xp + (long)row * D_MODEL : xs + (long)(row - NTOK) * D_MODEL; float* o = row < NTOK ? yp + (long)row * D_MODEL : ys + (long)(row - NTOK) * D_MODEL;
    float s = 0.f; for (int c = t; c < D_MODEL; c += 256) s += r[c] * r[c];
    s = block_sum256(s, sh, t); const float rstd = 1.0f / sqrtf(s / 1024.f + EPS);
    for (int c = t; c < D_MODEL; c += 256) o[c] = x[c] + r[c] * rstd * norm_post[c];
}
struct Bufs { float *H, *PROJ, *QN, *Q192, *QCAT, *KCAT, *S, *OLAT, *XACT, *Y, *MIX, *OUTP, *DSC; };
__host__ __device__ inline void carve(unsigned char* base, size_t& off, size_t bytes, float** p) { *p = (float*)(base + off); off += (bytes + 255) & ~(size_t)255; }
__host__ __device__ inline void make_bufs(unsigned char* ws, Bufs& B) {
    size_t off = (size_t)1 << 30;
    carve(ws, off, (size_t)MT * 1024 * 4, &B.H); carve(ws, off, (size_t)MT * NPROJ * 4, &B.PROJ); carve(ws, off, (size_t)MT * 384 * 4, &B.QN); carve(ws, off, (size_t)MT * 1536 * 4, &B.Q192);
    carve(ws, off, (size_t)MT * 8 * QK * 4, &B.QCAT); carve(ws, off, (size_t)MT * QK * 4, &B.KCAT); carve(ws, off, (size_t)BATCH * SEQ * 8 * SEQ * 4, &B.S); carve(ws, off, (size_t)MT * 8 * KVR * 4, &B.OLAT);
    carve(ws, off, (size_t)MT * CONVD * 4, &B.XACT); carve(ws, off, (size_t)MT * DSSM * 4, &B.Y); carve(ws, off, (size_t)MT * DMIX * 4, &B.MIX); carve(ws, off, (size_t)MT * 1024 * 4, &B.OUTP);
    carve(ws, off, (size_t)DEC * 8 * 8256 * 4, &B.DSC);
}
}
namespace mk {
using namespace nv;
typedef unsigned short bf16;
typedef unsigned v4u __attribute__((ext_vector_type(4)));
typedef unsigned v2u __attribute__((ext_vector_type(2)));
typedef float f32x4 __attribute__((ext_vector_type(4)));
typedef float f32x2 __attribute__((ext_vector_type(2)));
typedef short bf16x8 __attribute__((ext_vector_type(8)));
constexpr int MP = 16640;
constexpr int N1P = 4352;
#define LDS_WAIT() asm volatile("s_waitcnt lgkmcnt(0)" ::: "memory")
#define VM_WAIT() asm volatile("s_waitcnt vmcnt(0)" ::: "memory")
__device__ __forceinline__ unsigned f2bf(float f) { unsigned u = __builtin_bit_cast(unsigned, f); return (u + 0x7fffu + ((u >> 16) & 1u)) >> 16; }
__device__ __forceinline__ unsigned pk2(float lo, float hi) { return f2bf(lo) | (f2bf(hi) << 16); }
__device__ __forceinline__ float bf2f(unsigned short b) { return __builtin_bit_cast(float, (unsigned)b << 16); }
__device__ __forceinline__ float wave_sum(float v) {
#pragma unroll
    for (int o = 1; o < 64; o <<= 1) v += __shfl_xor(v, o);
    return v;
}
constexpr size_t MiB = 1u << 20;
constexpr size_t WS_WIN = 2 * MiB;
constexpr size_t WS_XN = 16 * MiB;
__device__ __forceinline__ void p0_transpose_item(const float* W, int K, int N, const float* kscale, int ksoff, bf16* WT, int row_off, LAS float* scr, int item, int nblk, int lane) {
    const int kb = item / nblk, nb = item % nblk, k0 = 64 * kb, n0 = 32 * nb;
#pragma unroll 8
    for (int i = 0; i < 32; ++i) { const int kk = 2 * i + (lane >> 5); const int n = n0 + (lane & 31);
        float v = (n < N) ? W[(size_t)(k0 + kk) * N + n] : 0.f; if (kscale && k0 + kk >= ksoff) v *= kscale[k0 + kk - ksoff]; scr[kk * 33 + (lane & 31)] = v; }
    LDS_WAIT(); asm volatile("" ::: "memory");
    const int c = lane & 7;
#pragma unroll
    for (int j = 0; j < 4; ++j) { const int n = (lane >> 3) + 8 * j; const LAS float* s = scr + (8 * c) * 33 + n;
        v4u o; o.x = pk2(s[0 * 33], s[1 * 33]); o.y = pk2(s[2 * 33], s[3 * 33]); o.z = pk2(s[4 * 33], s[5 * 33]); o.w = pk2(s[6 * 33], s[7 * 33]);
        *(GAS v4u*)(WT + (size_t)(row_off + n0 + n) * K + k0 + 8 * c) = o; }
    LDS_WAIT(); asm volatile("" ::: "memory");
}
__device__ __forceinline__ void xn_row(const float* xrow, bf16* orow, int lane) {
    GAS unsigned long long* o8 = (GAS unsigned long long*)orow + lane;
    if (!xrow) {
#pragma unroll
        for (int j = 0; j < 4; ++j) o8[64 * j] = 0ull;
        return; }
    const GAS f32x4* xr = (const GAS f32x4*)xrow + lane;
    f32x4 v[4]; float s = 0.f;
#pragma unroll
    for (int j = 0; j < 4; ++j) { v[j] = xr[64 * j]; s += (v[j].x * v[j].x + v[j].y * v[j].y) + (v[j].z * v[j].z + v[j].w * v[j].w); }
    const float rstd = 1.f / sqrtf(wave_sum(s) * (1.f / 1024.f) + EPS);
#pragma unroll
    for (int j = 0; j < 4; ++j) o8[64 * j] = (unsigned long long)pk2(v[j].x * rstd, v[j].y * rstd) | ((unsigned long long)pk2(v[j].z * rstd, v[j].w * rstd) << 32);
}
}
namespace mk {
constexpr size_t WS_WQ = 12 * MiB;
constexpr size_t WS_TAB = 14 * MiB + 512 * 1024;
constexpr size_t WS_QA = 50 * MiB;
constexpr size_t WS_KB = 64 * MiB;
constexpr size_t WS_DTV = 76 * MiB;
constexpr size_t WS_QB = 80 * MiB;
constexpr size_t WS_XACT = 164 * MiB;
constexpr size_t WS_WOUT = 216 * MiB;
constexpr size_t WS_MIX = 224 * MiB;
constexpr size_t CTL_SSQ2 = 65536 + 131072;
constexpr size_t WS_KRR = 304 * MiB;
constexpr size_t WS_DTR = 296 * MiB;
constexpr size_t WS_XBR = 320 * MiB;
constexpr size_t WS_ZA = 372 * MiB;
constexpr size_t WS_ZS = 408 * MiB;
constexpr size_t CTL_SSQG = 65536 + 3 * 131072;
constexpr size_t CTL_SSQ = 65536;
constexpr float QSCALE = 0.07216878364870322f * 1.4426950408889634f;
__device__ __forceinline__ void tab_item(float* tab, int idx) { const int p = idx >> 5, j = idx & 31; float c, s; rope_cs(p < 2048 ? p : PAST, j, c, s); tab[p * 64 + j] = c; tab[p * 64 + 32 + j] = s; }
__device__ __forceinline__ void wq_item(const float* w_q_b, const float* w_uk, const float* q_a_norm, bf16* WQ, int item, int lane) {
    const int h = item / 320, cc = item % 320;
#pragma unroll 1
    for (int i = 0; i < 6; ++i) { const int k = lane + 64 * i; float a = 0.f;
        if (cc < 256) { const f32x4* wr = (const f32x4*)(w_q_b + (size_t)k * 1536 + h * 192); const f32x4* ur = (const f32x4*)(w_uk + ((size_t)cc * 8 + h) * 128);
#pragma unroll 8
            for (int n = 0; n < 32; ++n) { const f32x4 x = wr[n], y = ur[n]; a += (x.x * y.x + x.y * y.y) + (x.z * y.z + x.w * y.w); } }
        else { const int e = (cc - 256) & 1, j = (cc - 256) >> 1; a = w_q_b[(size_t)k * 1536 + h * 192 + 128 + 32 * e + j]; }
        WQ[(size_t)item * 384 + k] = (bf16)f2bf(a * q_a_norm[k]); }
}
__device__ __forceinline__ float softplusf(float v) { return v > 20.f ? v : log1pf(expf(v)); }
__device__ __forceinline__ float silu_fast(float v) { return v / (1.0f + __expf(-v)); }
__device__ __forceinline__ void p2_row(int row, int lane, const float* KRR, const float* DTR, const bf16* XBR, const float* kv_a_norm, const float* tab, const float* dt_bias, const float* conv_w, const float* conv_b, const float* state_conv,
                                       bf16* KB, float* DTV, bf16* XACT, float* ckv_p, float* ckv_s, float* kr_p, float* kr_s, float* conv_s) {
    const int pidx = row < NTOK ? (row % SEQ) : 2048;
    {
        float* dst = row < NTOK ? ckv_p + (size_t)row * 256 : ckv_s + (size_t)(row - NTOK) * 256;
        const f32x4 v = *(const f32x4*)(dst + 4 * lane); const float ss = wave_sum((v.x * v.x + v.y * v.y) + (v.z * v.z + v.w * v.w));
        const float rstd = 1.0f / sqrtf(ss * (1.f / 256.f) + EPS); const f32x4 w = *(const f32x4*)(kv_a_norm + 4 * lane); const f32x4 o = v * rstd * w;
        *(f32x4*)(dst + 4 * lane) = o;
        v2u pk; pk.x = pk2(o.x, o.y); pk.y = pk2(o.z, o.w); *(v2u*)(KB + (size_t)row * QK + 4 * lane) = pk; }
    if (lane < 32) {
        const float x1 = KRR[(size_t)row * 64 + lane], x2 = KRR[(size_t)row * 64 + 32 + lane], c = tab[pidx * 64 + lane], s = tab[pidx * 64 + 32 + lane];
        const float a = x1 * c - x2 * s, b = x1 * s + x2 * c; float* dst = row < NTOK ? kr_p + (size_t)row * 64 : kr_s + (size_t)(row - NTOK) * 64; dst[lane] = a; dst[32 + lane] = b;
        KB[(size_t)row * QK + 256 + lane] = (bf16)f2bf(a); KB[(size_t)row * QK + 288 + lane] = (bf16)f2bf(b); }
    if (lane < 16) DTV[(size_t)row * 16 + lane] = softplusf(DTR[(size_t)row * 16 + lane] + dt_bias[lane]);
#pragma unroll 1
    for (int i = 0; i < 3; ++i) {
        const int c0 = 8 * lane + 512 * i; float xp[4][8];
        if (row < NTOK) { const int s = row % SEQ;
#pragma unroll
            for (int k = 0; k < 4; ++k) { const bool ok = s + k - 3 >= 0; const v4u w = ok ? *(const v4u*)(XBR + (size_t)(row + k - 3) * CONVD + c0) : (v4u){0u, 0u, 0u, 0u};
                xp[k][0] = bf2f((unsigned short)(w.x & 0xffffu)); xp[k][1] = bf2f((unsigned short)(w.x >> 16)); xp[k][2] = bf2f((unsigned short)(w.y & 0xffffu)); xp[k][3] = bf2f((unsigned short)(w.y >> 16));
                xp[k][4] = bf2f((unsigned short)(w.z & 0xffffu)); xp[k][5] = bf2f((unsigned short)(w.z >> 16)); xp[k][6] = bf2f((unsigned short)(w.w & 0xffffu)); xp[k][7] = bf2f((unsigned short)(w.w >> 16)); } }
        else { const int b = row - NTOK;
#pragma unroll
            for (int k = 0; k < 3; ++k) { const float* src = state_conv + ((size_t)b * 3 + k) * CONVD + c0;
#pragma unroll
                for (int e = 0; e < 8; ++e) xp[k][e] = src[e]; }
            { const v4u w = *(const v4u*)(XBR + (size_t)row * CONVD + c0);
                xp[3][0] = bf2f((unsigned short)(w.x & 0xffffu)); xp[3][1] = bf2f((unsigned short)(w.x >> 16)); xp[3][2] = bf2f((unsigned short)(w.y & 0xffffu)); xp[3][3] = bf2f((unsigned short)(w.y >> 16));
                xp[3][4] = bf2f((unsigned short)(w.z & 0xffffu)); xp[3][5] = bf2f((unsigned short)(w.z >> 16)); xp[3][6] = bf2f((unsigned short)(w.w & 0xffffu)); xp[3][7] = bf2f((unsigned short)(w.w >> 16)); }
#pragma unroll
            for (int k = 0; k < 2; ++k) { float* d = conv_s + ((size_t)b * 3 + k) * CONVD + c0;
#pragma unroll
                for (int e = 0; e < 8; ++e) d[e] = xp[k + 1][e]; } }
        float o[8];
#pragma unroll
        for (int e = 0; e < 8; ++e) { float a = conv_b[c0 + e];
#pragma unroll
            for (int k = 0; k < 4; ++k) a += xp[k][e] * conv_w[k * CONVD + c0 + e];
            o[e] = siluf(a); }
        v4u pk; pk.x = pk2(o[0], o[1]); pk.y = pk2(o[2], o[3]); pk.z = pk2(o[4], o[5]); pk.w = pk2(o[6], o[7]);
        *(v4u*)(XACT + (size_t)row * CONVD + c0) = pk; }
}
}
namespace at {
using namespace mk;
typedef float f32x16 __attribute__((ext_vector_type(16)));
typedef short s16x4 __attribute__((ext_vector_type(4)));
constexpr int KVBUF = 40960, PX_OFF = 3 * KVBUF, PX_PAIR = 32 * 144, MX_OFF = PX_OFF + 4 * PX_PAIR, LB_OFF = MX_OFF + 1024, AT_LDS_END = LB_OFF + 1024;
constexpr size_t WS_WUVF = 292 * MiB;
__device__ __forceinline__ void wuvf_item(const float* w_uv, bf16* WUVF, int item, int lane) {
    const int vt = item & 3, s2 = (item >> 2) & 1, c = (item >> 3) & 3, kh = (item >> 5) & 1, head = item >> 6, vv = lane & 31, h2 = lane >> 5;
    unsigned w[4];
#pragma unroll
    for (int jj = 0; jj < 4; ++jj) { float e[2];
#pragma unroll
        for (int q = 0; q < 2; ++q) { const int j = 2 * jj + q, r = 128 * kh + 32 * c + 16 * s2 + 8 * (j >> 2) + 4 * h2 + (j & 3); e[q] = w_uv[((size_t)r * 8 + head) * 128 + 32 * vt + vv]; }
        w[jj] = pk2(e[0], e[1]); }
    *(v4u*)(WUVF + ((size_t)item * 64 + lane) * 8) = (v4u){w[0], w[1], w[2], w[3]};
}
__device__ __forceinline__ void glds16(const void* gsrc, unsigned lds_dst) { unsigned keep;
    asm volatile("s_mov_b32 %0, m0\n\ts_mov_b32 m0, %2\n\ts_nop 0\n\tglobal_load_lds_dwordx4 %1, off\n\ts_mov_b32 m0, %0" : "=&s"(keep) : "v"(gsrc), "s"(lds_dst) : "memory"); }
typedef float f32x2_t __attribute__((ext_vector_type(2))); typedef __bf16 bf16x2_t __attribute__((ext_vector_type(2)));
__device__ __forceinline__ unsigned cvtpk(float lo, float hi) { f32x2_t v = {lo, hi}; bf16x2_t b = __builtin_convertvector(v, bf16x2_t); return __builtin_bit_cast(unsigned, b); }
__device__ __forceinline__ s16x4 vtr(unsigned addr) { typedef short v4i16_t __attribute__((ext_vector_type(4))); return __builtin_bit_cast(s16x4, __builtin_amdgcn_ds_read_tr16_b64_v4i16((LAS v4i16_t*)(size_t)addr)); }
#define AT_BAR(N) asm volatile("s_waitcnt vmcnt(" #N ") lgkmcnt(0)\n\ts_barrier" ::: "memory")
#define AT_BARL() asm volatile("s_waitcnt lgkmcnt(0)\n\ts_barrier" ::: "memory")

__device__ __forceinline__ void attn_unit(LAS unsigned char* L, const bf16* __restrict__ QB, const bf16* __restrict__ KB, int b, int hg, int j, const bf16* __restrict__ WUVF, const bf16* __restrict__ ZA, bf16* __restrict__ MIX, int wave, int lane) {
    const int pair = wave >> 1, kh = wave & 1, h = hg * 4 + pair;
    const int q0 = 32 * j, NT = (j >> 1) + 1, rowbase = b * SEQ;
    const int ql = lane & 31, hh = lane >> 5;
    const unsigned lds0 = (unsigned)(size_t)L;
    bf16x8 qf[20];
    const bf16* kbase = KB + (size_t)rowbase * QK;
    unsigned soff0, soff4;
    { const int row4 = 4 * wave + (lane >> 4), ch = (lane & 15) ^ (((row4 & 3) << 2) | ((row4 >> 2) & 3));
      soff0 = (unsigned)(row4 * QK + 8 * ch);
      const int rb = wave >> 2, g = wave & 3, row8 = 8 * g + (lane >> 3), ch8 = (lane & 7) ^ ((row8 >> 1) & 7);
      soff4 = (unsigned)((32 * rb + row8) * QK + 256 + 8 * ch8); }
#define AT_DMA(t, bufi) do { const bf16* _s = kbase + (size_t)(t) * 64 * QK; const unsigned _d = lds0 + (bufi) * KVBUF + wave * 1024; \
        _Pragma("unroll") for (int _i = 0; _i < 4; ++_i) glds16(_s + soff0 + (32 * (_i >> 1) * QK + 128 * (_i & 1)), (unsigned)__builtin_amdgcn_readfirstlane(_d + _i * 8192)); \
        glds16(_s + soff4, (unsigned)__builtin_amdgcn_readfirstlane(_d + 32768)); } while (0)
    const unsigned wq = (unsigned)(hh ^ (((ql & 3) << 2) | ((ql >> 2) & 3)));
    const unsigned wr = (unsigned)(hh ^ ((ql >> 1) & 7));
    const unsigned ka = lds0 + (kh * 2) * 8192 + 256 * ql, kr = lds0 + 32768 + kh * 4096 + 128 * ql;
    unsigned vbase[2];
    { const int blk = (lane >> 4) & 1, qq = (lane & 15) >> 2, p = lane & 3, x = 2 * blk + (p >> 1);
#pragma unroll
      for (int t = 0; t < 2; ++t) { const int y = (2 * hh + t) & 3; vbase[t] = lds0 + (unsigned)(2048 * hh + 1024 * t + 256 * qq + 64 * qq + 16 * (x ^ y) + 8 * (p & 1)); } }
    const unsigned pxw = lds0 + PX_OFF + pair * PX_PAIR + ql * 144 + (32 * kh + 4 * hh) * 2;
    const unsigned pxr = lds0 + PX_OFF + pair * PX_PAIR + ql * 144 + 16 * hh;
    LAS float* MX = (LAS float*)(L + MX_OFF) + pair * 64; LAS float* LB = (LAS float*)(L + LB_OFF) + pair * 64;
    f32x16 oacc[4];
#pragma unroll
    for (int c = 0; c < 4; ++c) oacc[c] = (f32x16){};
    float m_ref = 0.f, lsum = 0.f;
    AT_DMA(0, 0); if (NT > 1) AT_DMA(1, 1);
    { const bf16* qp = QB + (size_t)(rowbase + q0 + ql) * 2560 + h * 320 + 8 * hh;
#pragma unroll
      for (int ks = 0; ks < 20; ++ks) qf[ks] = *(const bf16x8*)(qp + 16 * ks);
#pragma unroll
      for (int ks = 0; ks < 20; ++ks) asm volatile("" : "+v"(qf[ks])); }
    int buf = 0;
    for (int t = 0; t < NT; ++t) {
        if (t + 1 < NT) AT_BAR(5); else AT_BAR(0);
        if (t + 2 < NT) { const int nb = buf == 0 ? 2 : buf - 1; AT_DMA(t + 2, nb); }
        const unsigned kvb = (unsigned)buf * KVBUF;
        f32x16 sacc = (f32x16){};
#pragma unroll
        for (int g4 = 0; g4 < 5; ++g4) {
            bf16x8 kf[4];
#pragma unroll
            for (int i = 0; i < 4; ++i) { const int ks = 4 * g4 + i;
                if (ks < 16) kf[i] = *(const LAS bf16x8*)(size_t)(ka + kvb + (ks >> 3) * 8192 + 16 * ((unsigned)(2 * (ks & 7)) ^ wq));
                else kf[i] = *(const LAS bf16x8*)(size_t)(kr + kvb + 16 * ((unsigned)(2 * (ks - 16)) ^ wr)); }
#pragma unroll
            for (int i = 0; i < 4; ++i) sacc = __builtin_amdgcn_mfma_f32_32x32x16_bf16(kf[i], qf[4 * g4 + i], sacc, 0, 0, 0);
            asm volatile("" ::: "memory");
        }
        if (t == NT - 1) {
            const int qg = q0 + ql, kb0 = 64 * t + 32 * kh + 4 * hh;
#pragma unroll
            for (int r = 0; r < 16; ++r) { const int kg = kb0 + (r & 3) + 8 * (r >> 2); if (kg > qg) sacc[r] = -INFINITY; }
        }
        float mx = sacc[0];
#pragma unroll
        for (int r = 1; r < 16; ++r) mx = fmaxf(mx, sacc[r]);
        mx = fmaxf(mx, __shfl_xor(mx, 32));
#pragma unroll
        for (int r = 0; r < 16; ++r) { sacc[r] = __builtin_amdgcn_exp2f(sacc[r] - m_ref); lsum += sacc[r]; }
#pragma unroll
        for (int g = 0; g < 4; ++g) { v2u w; w.x = cvtpk(sacc[4 * g], sacc[4 * g + 1]); w.y = cvtpk(sacc[4 * g + 2], sacc[4 * g + 3]); *(LAS v2u*)(size_t)(pxw + 16 * g) = w; }
        if (hh == 0) MX[kh * 32 + ql] = mx;
        AT_BARL();
        const float mxp = MX[(kh ^ 1) * 32 + ql];
        bf16x8 pf[4];
#pragma unroll
        for (int i = 0; i < 4; ++i) pf[i] = *(const LAS bf16x8*)(size_t)(pxr + 64 * (i >> 1) + 32 * (i & 1));
#pragma unroll
        for (int i = 0; i < 4; ++i) {
            const unsigned vb = kvb + (unsigned)(((i >> 1) * 2 + kh) * 8192 + 4096 * (i & 1));
#pragma unroll
            for (int c = 0; c < 4; ++c) { const s16x4 lo = vtr((vbase[0] + vb) ^ (unsigned)(c << 6)), hi = vtr((vbase[1] + vb) ^ (unsigned)(c << 6));
                const bf16x8 vf = (bf16x8){lo[0], lo[1], lo[2], lo[3], hi[0], hi[1], hi[2], hi[3]};
                oacc[c] = __builtin_amdgcn_mfma_f32_32x32x16_bf16(vf, pf[i], oacc[c], 0, 0, 0); }
            asm volatile("" ::: "memory");
        }
        const float m_new = fmaxf(m_ref, fmaxf(mx, mxp));
        if (__any(m_new != m_ref)) { const float al = __builtin_amdgcn_exp2f(m_ref - m_new); lsum *= al;
#pragma unroll
            for (int c = 0; c < 4; ++c) oacc[c] *= al;
            m_ref = m_new; }
        buf = buf == 2 ? 0 : buf + 1;
    }
    lsum += __shfl_xor(lsum, 32);
    if (hh == 0) LB[kh * 32 + ql] = lsum;
    AT_BARL();
    { int l_; asm volatile("v_mbcnt_lo_u32_b32 %0, -1, 0\n\tv_mbcnt_hi_u32_b32 %0, -1, %0" : "=v"(l_)); lane = l_; }
    const int qe = lane & 31, he = lane >> 5;
    const float inv = 1.0f / (LB[qe] + LB[32 + qe]);
    f32x16 uacc[4];
#pragma unroll
    for (int vt = 0; vt < 4; ++vt) uacc[vt] = (f32x16){};
    { const bf16* wf = WUVF + ((size_t)((h * 2 + kh) * 32) * 64 + lane) * 8;
#pragma unroll
      for (int c = 0; c < 4; ++c)
#pragma unroll
        for (int s2 = 0; s2 < 2; ++s2) {
            v4u ow; ow.x = cvtpk(oacc[c][8 * s2], oacc[c][8 * s2 + 1]); ow.y = cvtpk(oacc[c][8 * s2 + 2], oacc[c][8 * s2 + 3]); ow.z = cvtpk(oacc[c][8 * s2 + 4], oacc[c][8 * s2 + 5]); ow.w = cvtpk(oacc[c][8 * s2 + 6], oacc[c][8 * s2 + 7]);
#pragma unroll
            for (int vt = 0; vt < 4; ++vt) { const bf16x8 af = *(const bf16x8*)(wf + (size_t)(((c * 2 + s2) * 4 + vt) * 64) * 8);
                uacc[vt] = __builtin_amdgcn_mfma_f32_32x32x16_bf16(af, __builtin_bit_cast(bf16x8, ow), uacc[vt], 0, 0, 0); } } }
    { LAS float* xs = (LAS float*)(L) + (pair * 2 + kh) * 2048 + lane; LAS float* xr = (LAS float*)(L) + (pair * 2 + (kh ^ 1)) * 2048 + lane;
      f32x16 keep0, keep1;
      if (kh == 0) { keep0 = uacc[0]; keep1 = uacc[1];
#pragma unroll
          for (int r = 0; r < 16; ++r) { xs[r * 64] = uacc[2][r]; xs[(16 + r) * 64] = uacc[3][r]; } }
      else { keep0 = uacc[2]; keep1 = uacc[3];
#pragma unroll
          for (int r = 0; r < 16; ++r) { xs[r * 64] = uacc[0][r]; xs[(16 + r) * 64] = uacc[1][r]; } }
      AT_BARL();
      const bf16* zr = ZA + (size_t)(rowbase + q0 + qe) * 1024 + h * 128 + 64 * kh + 4 * he;
      bf16* mr = MIX + (size_t)(rowbase + q0 + qe) * DMIX + h * 128 + 64 * kh + 4 * he;
#pragma unroll
      for (int ti = 0; ti < 2; ++ti)
#pragma unroll
        for (int g = 0; g < 4; ++g) { const v2u zw = *(const v2u*)(zr + 32 * ti + 8 * g); const float z[4] = {bf2f((unsigned short)(zw.x & 0xffffu)), bf2f((unsigned short)(zw.x >> 16)), bf2f((unsigned short)(zw.y & 0xffffu)), bf2f((unsigned short)(zw.y >> 16))}; float o[4];
#pragma unroll
            for (int e = 0; e < 4; ++e) { const int r = 4 * g + e; o[e] = ((ti == 0 ? keep0[r] : keep1[r]) + xr[(ti * 16 + r) * 64]) * inv * z[e]; }
            v2u w; w.x = cvtpk(o[0], o[1]); w.y = cvtpk(o[2], o[3]); *(v2u*)(mr + 32 * ti + 8 * g) = w; }
      AT_BARL(); }
#undef AT_DMA
}
__device__ __forceinline__ void attn_phase(LAS unsigned char* L, const bf16* QB, const bf16* KB, const bf16* WUVF, const bf16* ZA, bf16* MIX, int wave, int lane) {
    for (int pi = blockIdx.x; pi < 512; pi += gridDim.x) { const int bh = pi >> 5, jp = pi & 31;
        attn_unit(L, QB, KB, bh >> 1, bh & 1, 63 - jp, WUVF, ZA, MIX, wave, lane);
        attn_unit(L, QB, KB, bh >> 1, bh & 1, jp, WUVF, ZA, MIX, wave, lane); }
    asm volatile("s_waitcnt vmcnt(0) lgkmcnt(0)" ::: "memory");
}
}
namespace dc {
using namespace at;
constexpr int QS_OFF = 2 * KVBUF, QS_ROW = 656, DPX_OFF = QS_OFF + 32 * QS_ROW, DMX_OFF = DPX_OFF + PX_PAIR, DLB_OFF = DMX_OFF + 256, DFLAG_OFF = DLB_OFF + 256;
constexpr size_t WS_PART = 300 * MiB;
constexpr size_t CTL_DCNT = 65536 + 2 * 131072;
constexpr int PREC = 260;
typedef float f32x4n __attribute__((ext_vector_type(4)));
__device__ __forceinline__ f32x4 ldnt(const float* p) { return __builtin_nontemporal_load((const f32x4*)p); }

__device__ __forceinline__ void dec_unit(LAS unsigned char* L, const bf16* __restrict__ QB, const bf16* __restrict__ KB, const float* __restrict__ cache_ckv, const float* __restrict__ cache_kr,
                                         const int* __restrict__ page_table, int b, int split, float* PART, unsigned* DCNT, const float* __restrict__ w_uv, const bf16* __restrict__ ZA, bf16* __restrict__ MIX, int wave, int lane) {
    const int row = NTOK + b, ql = lane & 31, hh = lane >> 5;
    const unsigned lds0 = (unsigned)(size_t)L;
    { const int tid = wave * 64 + lane;
      for (int i = tid; i < 32 * 40; i += 512) { const int r = i / 40, c = i % 40; v4u v = (v4u){0u, 0u, 0u, 0u}; if (r < 8) v = *(const v4u*)(QB + (size_t)row * 2560 + r * 320 + 8 * c);
          *(LAS v4u*)(size_t)(lds0 + QS_OFF + r * QS_ROW + 16 * c) = v; } }
    const int* pt = page_table + b * NPAGES + split * 32;
    constexpr int NT = 64;
    f32x4 sa[10], sb[10];
#define DC_LOAD(dst, t) do { const size_t _pg = (size_t)__builtin_amdgcn_readfirstlane(pt[(t) >> 1]); const size_t _k0 = _pg * PAGE + 64 * ((t) & 1) + 8 * wave; \
        _Pragma("unroll") for (int _i = 0; _i < 8; ++_i) dst[_i] = ldnt(cache_ckv + (_k0 + _i) * KVR + 4 * lane); \
        _Pragma("unroll") for (int _i = 0; _i < 2; ++_i) dst[8 + _i] = ldnt(cache_kr + _k0 * ROPE + 256 * _i + 4 * lane); } while (0)
    const int rbw = wave >> 2;
    unsigned wck;
    { const int ch = lane >> 1; wck = (unsigned)((rbw * 2 + (ch >> 4)) * 8192 + 8 * (lane & 1)); }
#define DC_WRITE(src, bufb) do { \
        _Pragma("unroll") for (int _i = 0; _i < 8; ++_i) { const int _r = (8 * wave + _i) & 31; const unsigned _a = lds0 + (bufb) + wck + 256 * _r + 16 * ((unsigned)((lane >> 1) & 15) ^ (unsigned)(((_r & 3) << 2) | ((_r >> 2) & 3))); \
            v2u _w; _w.x = cvtpk(src[_i].x, src[_i].y); _w.y = cvtpk(src[_i].z, src[_i].w); *(LAS v2u*)(size_t)_a = _w; } \
        _Pragma("unroll") for (int _i = 0; _i < 2; ++_i) { const int _r = (8 * wave + 4 * _i + (lane >> 4)) & 31; const unsigned _a = lds0 + (bufb) + 32768 + rbw * 4096 + 128 * _r + 16 * ((unsigned)((lane & 15) >> 1) ^ (unsigned)((_r >> 1) & 7)) + 8 * (lane & 1); \
            v2u _w; _w.x = cvtpk(src[8 + _i].x, src[8 + _i].y); _w.y = cvtpk(src[8 + _i].z, src[8 + _i].w); *(LAS v2u*)(size_t)_a = _w; } } while (0)
    const int kh = wave & 1;
    const unsigned wq = (unsigned)(hh ^ (((ql & 3) << 2) | ((ql >> 2) & 3))), wr = (unsigned)(hh ^ ((ql >> 1) & 7));
    const unsigned ka = lds0 + (kh * 2) * 8192 + 256 * ql, kr = lds0 + 32768 + kh * 4096 + 128 * ql;
    unsigned vbase[2];
    { const int blk = (lane >> 4) & 1, qq = (lane & 15) >> 2, p = lane & 3, x = 2 * blk + (p >> 1);
#pragma unroll
      for (int t = 0; t < 2; ++t) { const int y = (2 * hh + t) & 3; vbase[t] = lds0 + (unsigned)(2048 * hh + 1024 * t + 256 * qq + 64 * qq + 16 * (x ^ y) + 8 * (p & 1)); } }
    const unsigned qsr = lds0 + QS_OFF + ql * QS_ROW + 16 * hh;
    const unsigned pxw = lds0 + DPX_OFF + ql * 144 + (32 * kh + 4 * hh) * 2, pxr = lds0 + DPX_OFF + ql * 144 + 16 * hh;
    LAS float* MX = (LAS float*)(L + DMX_OFF); LAS float* LB = (LAS float*)(L + DLB_OFF);
    f32x16 oacc = (f32x16){};
    float m_ref = 0.f, lsum = 0.f;
    DC_LOAD(sa, 0); DC_LOAD(sb, 1);
#define DC_TILE(src, t) do { const unsigned kvb = (unsigned)(((t) & 1) * KVBUF); \
        DC_WRITE(src, kvb); \
        if ((t) + 2 < NT) DC_LOAD(src, (t) + 2); \
        AT_BARL(); \
        float mx = 0.f; \
        if (wave < 2) { f32x16 sacc = (f32x16){}; \
            _Pragma("unroll") for (int g4 = 0; g4 < 5; ++g4) { bf16x8 kf[4], qv[4]; \
                _Pragma("unroll") for (int i = 0; i < 4; ++i) { const int ks = 4 * g4 + i; qv[i] = *(const LAS bf16x8*)(size_t)(qsr + 32 * ks); \
                    if (ks < 16) kf[i] = *(const LAS bf16x8*)(size_t)(ka + kvb + (ks >> 3) * 8192 + 16 * ((unsigned)(2 * (ks & 7)) ^ wq)); \
                    else kf[i] = *(const LAS bf16x8*)(size_t)(kr + kvb + 16 * ((unsigned)(2 * (ks - 16)) ^ wr)); } \
                _Pragma("unroll") for (int i = 0; i < 4; ++i) sacc = __builtin_amdgcn_mfma_f32_32x32x16_bf16(kf[i], qv[i], sacc, 0, 0, 0); \
                asm volatile("" ::: "memory"); } \
            mx = sacc[0]; \
            _Pragma("unroll") for (int r = 1; r < 16; ++r) mx = fmaxf(mx, sacc[r]); \
            mx = fmaxf(mx, __shfl_xor(mx, 32)); \
            _Pragma("unroll") for (int r = 0; r < 16; ++r) { sacc[r] = __builtin_amdgcn_exp2f(sacc[r] - m_ref); lsum += sacc[r]; } \
            _Pragma("unroll") for (int g = 0; g < 4; ++g) { v2u w; w.x = cvtpk(sacc[4 * g], sacc[4 * g + 1]); w.y = cvtpk(sacc[4 * g + 2], sacc[4 * g + 3]); *(LAS v2u*)(size_t)(pxw + 16 * g) = w; } \
            if (hh == 0) MX[kh * 32 + ql] = mx; } \
        AT_BARL(); \
        { const float m_new = fmaxf(m_ref, fmaxf(MX[ql], MX[32 + ql])); \
          bf16x8 pf[4]; \
          _Pragma("unroll") for (int i = 0; i < 4; ++i) pf[i] = *(const LAS bf16x8*)(size_t)(pxr + 64 * (i >> 1) + 32 * (i & 1)); \
          _Pragma("unroll") for (int i = 0; i < 4; ++i) { const unsigned vb = kvb + (unsigned)(((i >> 1) * 2 + (wave >> 2)) * 8192 + 4096 * (i & 1)); \
              const s16x4 lo = vtr((vbase[0] + vb) ^ (unsigned)((wave & 3) << 6)), hi = vtr((vbase[1] + vb) ^ (unsigned)((wave & 3) << 6)); \
              const bf16x8 vf = (bf16x8){lo[0], lo[1], lo[2], lo[3], hi[0], hi[1], hi[2], hi[3]}; \
              oacc = __builtin_amdgcn_mfma_f32_32x32x16_bf16(vf, pf[i], oacc, 0, 0, 0); } \
          if (__any(m_new != m_ref)) { const float al = __builtin_amdgcn_exp2f(m_ref - m_new); lsum *= al; oacc *= al; m_ref = m_new; } } \
    } while (0)
#pragma unroll 1
    for (int t = 0; t < NT; t += 2) { DC_TILE(sa, t); DC_TILE(sb, t + 1); }
    lsum += __shfl_xor(lsum, 32);
    if (wave < 2 && hh == 0) LB[kh * 32 + ql] = lsum;
    AT_BARL();
    float* pr = PART + ((size_t)(b * 2 + split) * 8) * PREC;
    if (ql < 8) { float* ph = pr + ql * PREC;
        if (wave == 0 && hh == 0) { ph[0] = m_ref; ph[1] = LB[ql] + LB[32 + ql]; }
#pragma unroll
        for (int g = 0; g < 4; ++g) *(f32x4*)(ph + 4 + 32 * wave + 8 * g + 4 * hh) = (f32x4){oacc[4 * g], oacc[4 * g + 1], oacc[4 * g + 2], oacc[4 * g + 3]}; }
    __threadfence();
    asm volatile("s_waitcnt vmcnt(0) lgkmcnt(0)\n\ts_barrier" ::: "memory");
    LAS unsigned* flag = (LAS unsigned*)(L + DFLAG_OFF);
    if (wave == 0 && lane == 0) { const unsigned old = __hip_atomic_fetch_add(DCNT + b, 1u, __ATOMIC_RELAXED, __HIP_MEMORY_SCOPE_AGENT); *flag = old; }
    AT_BARL();
    const unsigned old = *flag;
    if (old == 1u) {
        __builtin_amdgcn_fence(__ATOMIC_ACQUIRE, "agent");
        const int h = wave;
        const float* p0 = PART + ((size_t)(b * 2 + 0) * 8 + h) * PREC; const float* p1 = PART + ((size_t)(b * 2 + 1) * 8 + h) * PREC;
        const float m0 = __hip_atomic_load(p0, __ATOMIC_RELAXED, __HIP_MEMORY_SCOPE_AGENT), l0 = __hip_atomic_load(p0 + 1, __ATOMIC_RELAXED, __HIP_MEMORY_SCOPE_AGENT);
        const float m1 = __hip_atomic_load(p1, __ATOMIC_RELAXED, __HIP_MEMORY_SCOPE_AGENT), l1 = __hip_atomic_load(p1 + 1, __ATOMIC_RELAXED, __HIP_MEMORY_SCOPE_AGENT);
        const f32x4 o0 = *(const f32x4*)(p0 + 4 + 4 * lane), o1 = *(const f32x4*)(p1 + 4 + 4 * lane);
        const bf16* qrow = QB + (size_t)row * 2560 + h * 320; const bf16* krow = KB + (size_t)row * QK;
        float sn = 0.f;
#pragma unroll
        for (int i = 0; i < 5; ++i) sn += bf2f(qrow[lane + 64 * i]) * bf2f(krow[lane + 64 * i]);
        sn = wave_sum(sn);
        const float m = fmaxf(fmaxf(m0, m1), sn), w0 = __builtin_amdgcn_exp2f(m0 - m), w1 = __builtin_amdgcn_exp2f(m1 - m), wn = __builtin_amdgcn_exp2f(sn - m);
        const float inv = 1.0f / (w0 * l0 + w1 * l1 + wn);
        const v2u kc = *(const v2u*)(krow + 4 * lane);
        const f32x4 cn = (f32x4){bf2f((unsigned short)(kc.x & 0xffffu)), bf2f((unsigned short)(kc.x >> 16)), bf2f((unsigned short)(kc.y & 0xffffu)), bf2f((unsigned short)(kc.y >> 16))};
        *(LAS f32x4*)(size_t)(lds0 + 16 * (h * 64 + lane)) = (o0 * w0 + o1 * w1 + cn * wn) * inv;
        asm volatile("s_waitcnt lgkmcnt(0)" ::: "memory");
        float a0 = 0.f, a1 = 0.f;
#pragma unroll 8
        for (int r = 0; r < 256; ++r) { const float ol = *(const LAS float*)(size_t)(lds0 + 4 * (h * 256 + r)); const f32x2 wv = *(const f32x2*)(w_uv + ((size_t)r * 8 + h) * 128 + 2 * lane); a0 += ol * wv.x; a1 += ol * wv.y; }
        const unsigned zw = *(const unsigned*)(ZA + (size_t)row * 1024 + h * 128 + 2 * lane);
        *(unsigned*)(MIX + (size_t)row * DMIX + h * 128 + 2 * lane) = cvtpk(a0 * bf2f((unsigned short)(zw & 0xffffu)), a1 * bf2f((unsigned short)(zw >> 16)));
    }
    AT_BARL();
#undef DC_LOAD
#undef DC_WRITE
#undef DC_TILE
}
__device__ __forceinline__ void dec_phase(LAS unsigned char* L, const bf16* QB, const bf16* KB, const float* cache_ckv, const float* cache_kr, const int* page_table, unsigned char* ws, const float* w_uv, const bf16* ZA, bf16* MIX, int wave, int lane) {
    for (int u = blockIdx.x; u < 256; u += gridDim.x) dec_unit(L, QB, KB, cache_ckv, cache_kr, page_table, u >> 1, u & 1, (float*)(ws + WS_PART), (unsigned*)(ws + CTL_DCNT), w_uv, ZA, MIX, wave, lane);
}
}
namespace sd {
using namespace at;
constexpr int CI_OFF = 0, BI_OFF = 32768, XT_OFF = 65536, XROW = 272, XE_OFF = XT_OFF + 64 * XROW, SB_OFF = XE_OFF + 64 * XROW, AC_OFF = SB_OFF + 64 * XROW, DT_OFF = AC_OFF + 512, SD_END = DT_OFF + 512;
constexpr float LOG2E = 1.4426950408889634f;

__device__ __forceinline__ void ssd_unit(LAS unsigned char* L, const bf16* __restrict__ XACT, const float* __restrict__ DTV, const float* __restrict__ a_log, const float* __restrict__ d_skip, const bf16* __restrict__ ZS, int b, int hd,
                                         bf16* __restrict__ MIX, float* __restrict__ SSQG, float* __restrict__ HOUT, int wave, int lane) {
    const int g = hd >> 3, ql = lane & 31, hh = lane >> 5, tid = wave * 64 + lane;
    const unsigned lds0 = (unsigned)(size_t)L;
    const int pt = wave >> 2, lt = pt == 0 ? (wave & 3) : 3 - (wave & 3), nt = wave & 3;
    const float A2 = -expf(a_log[hd]) * LOG2E;
    unsigned soffC, soffB;
    { const int row4 = 4 * wave + (lane >> 4), ch = (lane & 15) ^ (((row4 & 3) << 2) | ((row4 >> 2) & 3));
      soffC = (unsigned)(row4 * CONVD + 1280 + g * 128 + 8 * ch); soffB = (unsigned)(row4 * CONVD + 1024 + g * 128 + 8 * ch); }
    const unsigned wq = (unsigned)(hh ^ (((ql & 3) << 2) | ((ql >> 2) & 3)));
    unsigned vbase[2];
    { const int blk = (lane >> 4) & 1, qq = (lane & 15) >> 2, p = lane & 3, x = 2 * blk + (p >> 1);
#pragma unroll
      for (int t = 0; t < 2; ++t) { const int y = (2 * hh + t) & 3; vbase[t] = lds0 + BI_OFF + (unsigned)(2048 * hh + 1024 * t + 256 * qq + 64 * qq + 16 * (x ^ y) + 8 * (p & 1)); } }
    LAS float* AC = (LAS float*)(L + AC_OFF); LAS float* DT = (LAS float*)(L + DT_OFF);
    for (int i = tid; i < 64 * XROW / 16; i += 512) *(LAS v4u*)(size_t)(lds0 + SB_OFF + 16 * i) = (v4u){0u, 0u, 0u, 0u};
    f32x16 sacc = (f32x16){};
#pragma unroll 1
    for (int c = 0; c < 16; ++c) {
        const int r0 = b * SEQ + 128 * c;
        { const bf16* src = XACT + (size_t)r0 * CONVD;
#pragma unroll
          for (int lb = 0; lb < 4; ++lb) { glds16(src + (size_t)(32 * lb) * CONVD + soffC, (unsigned)__builtin_amdgcn_readfirstlane(lds0 + CI_OFF + lb * 8192 + wave * 1024));
                                           glds16(src + (size_t)(32 * lb) * CONVD + soffB, (unsigned)__builtin_amdgcn_readfirstlane(lds0 + BI_OFF + lb * 8192 + wave * 1024)); } }
        if (wave == 0) {
            const float d0 = DTV[(size_t)(r0 + lane) * 16 + hd], d1 = DTV[(size_t)(r0 + 64 + lane) * 16 + hd];
            float v0 = d0 * A2, v1 = d1 * A2;
#pragma unroll
            for (int o = 1; o < 64; o <<= 1) { const float u0 = __shfl_up(v0, o), u1 = __shfl_up(v1, o); if (lane >= o) { v0 += u0; v1 += u1; } }
            v1 += __shfl(v0, 63);
            AC[lane] = v0; AC[64 + lane] = v1; DT[lane] = d0; DT[64 + lane] = d1;
        }
        AT_BARL();
        { const int s = tid & 127, pg = tid >> 7; const float dts = DT[s], de = dts * __builtin_amdgcn_exp2f(AC[127] - AC[s]);
          const bf16* xs = XACT + (size_t)(r0 + s) * CONVD + hd * 64 + 16 * pg; const v4u xa = *(const v4u*)xs, xb = *(const v4u*)(xs + 8);
          const unsigned xw[8] = {xa.x, xa.y, xa.z, xa.w, xb.x, xb.y, xb.z, xb.w};
#pragma unroll
          for (int e = 0; e < 16; ++e) { const float xv = bf2f((unsigned short)((e & 1) ? (xw[e >> 1] >> 16) : (xw[e >> 1] & 0xffffu)));
              const unsigned a = (unsigned)((16 * pg + e) * XROW + 2 * s);
              *(LAS unsigned short*)(size_t)(lds0 + XT_OFF + a) = (unsigned short)f2bf(xv * dts); *(LAS unsigned short*)(size_t)(lds0 + XE_OFF + a) = (unsigned short)f2bf(xv * de); } }
        asm volatile("s_waitcnt vmcnt(0) lgkmcnt(0)\n\ts_barrier" ::: "memory");
        bf16x8 cf[8];
#pragma unroll
        for (int kk = 0; kk < 8; ++kk) cf[kk] = *(const LAS bf16x8*)(size_t)(lds0 + CI_OFF + lt * 8192 + 256 * ql + 16 * ((unsigned)(2 * kk) ^ wq));
        f32x16 yacc = (f32x16){};
#pragma unroll
        for (int kk = 0; kk < 8; ++kk) { const bf16x8 af = *(const LAS bf16x8*)(size_t)(lds0 + SB_OFF + (32 * pt + ql) * XROW + 2 * (16 * kk + 8 * hh));
            yacc = __builtin_amdgcn_mfma_f32_32x32x16_bf16(af, cf[kk], yacc, 0, 0, 0); }
        const float acl = AC[32 * lt + ql];
        yacc *= __builtin_amdgcn_exp2f(acl);
        for (int sb = 0; sb <= lt; ++sb) {
            f32x16 gacc = (f32x16){};
#pragma unroll
            for (int kk = 0; kk < 8; ++kk) { const bf16x8 bfr = *(const LAS bf16x8*)(size_t)(lds0 + BI_OFF + sb * 8192 + 256 * ql + 16 * ((unsigned)(2 * kk) ^ wq));
                gacc = __builtin_amdgcn_mfma_f32_32x32x16_bf16(bfr, cf[kk], gacc, 0, 0, 0); }
            const int lidx = 32 * lt + ql;
#pragma unroll
            for (int g4 = 0; g4 < 4; ++g4) { const int s0 = 32 * sb + 8 * g4 + 4 * hh; const f32x4 as = *(const LAS f32x4*)(size_t)(lds0 + AC_OFF + 4 * s0);
#pragma unroll
                for (int e = 0; e < 4; ++e) { const float f = __builtin_amdgcn_exp2f(acl - as[e]); gacc[4 * g4 + e] = (s0 + e <= lidx) ? gacc[4 * g4 + e] * f : 0.f; } }
#pragma unroll
            for (int s2 = 0; s2 < 2; ++s2) {
                v4u gw; gw.x = cvtpk(gacc[8 * s2], gacc[8 * s2 + 1]); gw.y = cvtpk(gacc[8 * s2 + 2], gacc[8 * s2 + 3]); gw.z = cvtpk(gacc[8 * s2 + 4], gacc[8 * s2 + 5]); gw.w = cvtpk(gacc[8 * s2 + 6], gacc[8 * s2 + 7]);
                const unsigned xa = lds0 + XT_OFF + (unsigned)((32 * pt + ql) * XROW + 2 * (32 * sb + 16 * s2 + 4 * hh));
                const v2u x0 = *(const LAS v2u*)(size_t)xa, x1 = *(const LAS v2u*)(size_t)(xa + 16);
                const v4u xf = (v4u){x0.x, x0.y, x1.x, x1.y};
                yacc = __builtin_amdgcn_mfma_f32_32x32x16_bf16(__builtin_bit_cast(bf16x8, xf), __builtin_bit_cast(bf16x8, gw), yacc, 0, 0, 0); }
        }
        { int le; asm volatile("v_mbcnt_lo_u32_b32 %0, -1, 0\n\tv_mbcnt_hi_u32_b32 %0, -1, %0" : "=v"(le));
          const int qe = le & 31, he = le >> 5; const size_t rowg = (size_t)(r0 + 32 * lt + qe); const int c0 = hd * 64 + 32 * pt + 4 * he;
          const bf16* xp = XACT + rowg * CONVD + c0; const bf16* zp = ZS + rowg * 1024 + c0; bf16* mp = MIX + rowg * DMIX + 1024 + c0;
          const float dsk = d_skip[hd]; float ss = 0.f;
#pragma unroll
          for (int g4 = 0; g4 < 4; ++g4) { const v2u xw = *(const v2u*)(xp + 8 * g4); const v2u zw = *(const v2u*)(zp + 8 * g4); const float z[4] = {bf2f((unsigned short)(zw.x & 0xffffu)), bf2f((unsigned short)(zw.x >> 16)), bf2f((unsigned short)(zw.y & 0xffffu)), bf2f((unsigned short)(zw.y >> 16))};
              const float xv[4] = {bf2f((unsigned short)(xw.x & 0xffffu)), bf2f((unsigned short)(xw.x >> 16)), bf2f((unsigned short)(xw.y & 0xffffu)), bf2f((unsigned short)(xw.y >> 16))}; float o[4];
#pragma unroll
              for (int e = 0; e < 4; ++e) { o[e] = (yacc[4 * g4 + e] + dsk * xv[e]) * z[e]; ss += o[e] * o[e]; }
              v2u w; w.x = cvtpk(o[0], o[1]); w.y = cvtpk(o[2], o[3]); *(v2u*)(mp + 8 * g4) = w; }
          ss += __shfl_xor(ss, 32);
          if (he == 0) atomicAdd(SSQG + rowg * 2 + g, ss); }
        sacc *= __builtin_amdgcn_exp2f(AC[127]);
#pragma unroll
        for (int kk = 0; kk < 8; ++kk) { const bf16x8 af = *(const LAS bf16x8*)(size_t)(lds0 + XE_OFF + (32 * pt + ql) * XROW + 2 * (16 * kk + 8 * hh));
            const unsigned vb = (unsigned)((kk >> 1) * 8192 + 4096 * (kk & 1));
            const s16x4 lo = vtr((vbase[0] + vb) ^ (unsigned)(nt << 6)), hi = vtr((vbase[1] + vb) ^ (unsigned)(nt << 6));
            const bf16x8 bfr = (bf16x8){lo[0], lo[1], lo[2], lo[3], hi[0], hi[1], hi[2], hi[3]};
            sacc = __builtin_amdgcn_mfma_f32_32x32x16_bf16(af, bfr, sacc, 0, 0, 0); }
        AT_BARL();
        if (c < 15) {
#pragma unroll
            for (int r = 0; r < 16; ++r) { const int p = 32 * pt + (r & 3) + 8 * (r >> 2) + 4 * hh;
                *(LAS unsigned short*)(size_t)(lds0 + SB_OFF + p * XROW + 2 * (32 * nt + ql)) = (unsigned short)f2bf(sacc[r]); }
        }
    }
    { float* hp = HOUT + ((size_t)(b * 16 + hd) * 64) * 128 + 32 * nt + ql;
#pragma unroll
      for (int r = 0; r < 16; ++r) hp[(size_t)(32 * pt + (r & 3) + 8 * (r >> 2) + 4 * hh) * 128] = sacc[r]; }
    AT_BARL();
}
__device__ __forceinline__ void ssd_phase(LAS unsigned char* L, const bf16* XACT, const float* DTV, const float* a_log, const float* d_skip, const bf16* ZS, bf16* MIX, float* SSQG, float* HOUT, int wave, int lane) {
    for (int u = blockIdx.x; u < 128; u += gridDim.x) ssd_unit(L, XACT, DTV, a_log, d_skip, ZS, u >> 4, u & 15, MIX, SSQG, HOUT, wave, lane);
    asm volatile("s_waitcnt vmcnt(0) lgkmcnt(0)" ::: "memory");
}
__device__ __forceinline__ void ssd_dec_unit(LAS unsigned char* L, const bf16* __restrict__ XACT, const float* __restrict__ DTV, const float* __restrict__ a_log, const float* __restrict__ d_skip, const bf16* __restrict__ ZS,
                                             const float* __restrict__ h0, int b, int g, bf16* __restrict__ MIX, float* __restrict__ HOUT, int wave, int lane) {
    const int hd = g * 8 + wave, row = NTOK + b, n4 = lane & 31, pr = lane >> 5;
    const bf16* xr = XACT + (size_t)row * CONVD;
    const float dt = DTV[(size_t)row * 16 + hd], dec = expf(-expf(a_log[hd]) * dt);
    const v2u bw = *(const v2u*)(xr + 1024 + g * 128 + 4 * n4), cw = *(const v2u*)(xr + 1280 + g * 128 + 4 * n4);
    const f32x4 Bv = (f32x4){bf2f((unsigned short)(bw.x & 0xffffu)), bf2f((unsigned short)(bw.x >> 16)), bf2f((unsigned short)(bw.y & 0xffffu)), bf2f((unsigned short)(bw.y >> 16))};
    const f32x4 Cv = (f32x4){bf2f((unsigned short)(cw.x & 0xffffu)), bf2f((unsigned short)(cw.x >> 16)), bf2f((unsigned short)(cw.y & 0xffffu)), bf2f((unsigned short)(cw.y >> 16))};
    const float* hin = h0 + ((size_t)(b * 16 + hd) * 64) * 128 + 4 * n4; float* hout = HOUT + ((size_t)(b * 16 + hd) * 64) * 128 + 4 * n4;
    LAS float* GY = (LAS float*)L + wave * 64;
    const float dsk = d_skip[hd];
#pragma unroll 4
    for (int i = 0; i < 32; ++i) { const int p = 2 * i + pr; const float xv = bf2f(xr[hd * 64 + p]);
        f32x4 h = __builtin_nontemporal_load((const f32x4*)(hin + (size_t)p * 128)); h = h * dec + Bv * (xv * dt);
        __builtin_nontemporal_store(h, (f32x4*)(hout + (size_t)p * 128));
        float y = (h.x * Cv.x + h.y * Cv.y) + (h.z * Cv.z + h.w * Cv.w);
#pragma unroll
        for (int o = 1; o < 32; o <<= 1) y += __shfl_xor(y, o);
        if (n4 == 0) GY[p] = (y + dsk * xv) * bf2f(ZS[(size_t)row * 1024 + hd * 64 + p]); }
    AT_BARL();
    { LAS float* G = (LAS float*)L; const int tid = wave * 64 + lane; const float v = G[tid]; float ss = wave_sum(v * v);
      LAS float* RS = (LAS float*)L + 512; if (lane == 0) RS[wave] = ss;
      AT_BARL();
      float tot = 0.f;
#pragma unroll
      for (int w = 0; w < 8; ++w) tot += RS[w];
      const float rstd = 1.0f / sqrtf(tot * (1.f / 512.f) + EPS);
      MIX[(size_t)row * DMIX + 1024 + g * 512 + tid] = (bf16)f2bf(v * rstd); }
    AT_BARL();
}
__device__ __forceinline__ void ssd_dec_phase(LAS unsigned char* L, const bf16* XACT, const float* DTV, const float* a_log, const float* d_skip, const bf16* ZS, const float* h0, bf16* MIX, float* HOUT, int wave, int lane) {
    for (int u = blockIdx.x; u < 256; u += gridDim.x) ssd_dec_unit(L, XACT, DTV, a_log, d_skip, ZS, h0, u >> 1, u & 1, MIX, HOUT, wave, lane);
    asm volatile("s_waitcnt vmcnt(0) lgkmcnt(0)" ::: "memory");
}
__device__ __forceinline__ void ssd_norm_rows(bf16* MIX, const float* SSQG, int gw, int NGW, int lane) {
    for (int m = gw; m < NTOK; m += NGW) { const float r0 = 1.0f / sqrtf(SSQG[2 * m] * (1.f / 512.f) + EPS), r1 = 1.0f / sqrtf(SSQG[2 * m + 1] * (1.f / 512.f) + EPS);
        v4u* p = (v4u*)(MIX + (size_t)m * DMIX + 1024) + lane;
#pragma unroll
        for (int j = 0; j < 2; ++j) { v4u w = p[64 * j]; const float rs = j ? r1 : r0; unsigned* wp = (unsigned*)&w;
#pragma unroll
            for (int e = 0; e < 4; ++e) wp[e] = pk2(bf2f((unsigned short)(wp[e] & 0xffffu)) * rs, bf2f((unsigned short)(wp[e] >> 16)) * rs);
            p[64 * j] = w; } }
}
}
namespace pg8 {
#define PG8_LAS __attribute__((address_space(3)))
typedef unsigned short bf16_t;
typedef short bf16x8 __attribute__((ext_vector_type(8)));
typedef float f32x4 __attribute__((ext_vector_type(4)));
typedef unsigned u32x4 __attribute__((ext_vector_type(4)));
constexpr int BM = 256, BK = 64, HALF = 128, HTB = HALF * BK * 2  , STAGE_BYTES = 8 * HTB, NXCD = 8, WGM = 8;

__host__ __device__ __forceinline__ int lds_byte(int r, int c) { const int st = (r >> 4) * 2 + (c >> 5), rr = r & 15, cc = c & 31, ob = rr * 64 + cc * 2; return st * 1024 + (ob ^ (((ob >> 9) & 1) << 5)); }
__host__ __device__ __forceinline__ void stage_rc(int b, int& R, int& C) { const int st = b / 1024, sb = b % 1024, swz = sb ^ (((sb >> 9) & 1) << 5); R = (st >> 1) * 16 + swz / 64; C = (st & 1) * 32 + (swz % 64) / 2; }
__host__ __device__ __forceinline__ int perm32(int rho) { const int n = rho >> 4, i = rho & 15; return 8 * (i >> 2) + 4 * n + (i & 3); }

struct Unit { int pm, pn; };
struct Gemm { const bf16_t* A; const bf16_t* Bt; int M, N, K; };

struct StaticOrder {
    int nM, nN, nwg, G, c;
    __host__ __device__ void init(int M, int N, int G_, int c_) { nM = M / BM; nN = N / BM; nwg = nM * nN; G = G_; c = c_; }
    __host__ __device__ bool next(int i, Unit& u) const {
        const long L = (long)i * G + c; if (L >= nwg) return false;
        int wgid = (int)L; { const int q = nwg / NXCD, r = nwg % NXCD, xcd = wgid % NXCD, off = wgid / NXCD; wgid = (xcd < r ? xcd * (q + 1) : r * (q + 1) + (xcd - r) * q) + off; }
        const int nig = WGM * nN, gid = wgid / nig, fm = gid * WGM, gsz = (nM - fm) < WGM ? (nM - fm) : WGM;
        u.pm = fm + ((wgid % nig) % gsz); u.pn = (wgid % nig) / gsz; return true;
    }
    __device__ __forceinline__ void a_ready(const Unit&) const {}
    __device__ __forceinline__ void done(const Unit&) const {}
};

__device__ __forceinline__ unsigned cvt_pk_bf16(float lo, float hi) { unsigned r; asm volatile("v_cvt_pk_bf16_f32 %0, %1, %2" : "=v"(r) : "v"(lo), "v"(hi)); return r; }
typedef float f32x2 __attribute__((ext_vector_type(2)));
template <class Epi, class Sched, bool ALIGN_EPI = false, bool SP2 = false>
__device__ __forceinline__ void gemm_phase(PG8_LAS unsigned char* lds, const Gemm g, const Sched& S, const Epi& E, int wid_in) {
    int lane; asm volatile("v_mbcnt_lo_u32_b32 %0, -1, 0\n\tv_mbcnt_hi_u32_b32 %0, -1, %0" : "=v"(lane));
    const int wid = wid_in, tid = wid * 64 + lane, wr = wid >> 2, wc = wid & 3, fr = lane & 15, fq = lane >> 4;
    const int K = g.K, nt = K / BK;
    unsigned voffA[2], voffB[2];
#pragma unroll
    for (int i = 0; i < 2; ++i) { int R, C; stage_rc(tid * 16 + i * 8192, R, C); const int Rb = Epi::PERM ? ((R & ~31) + perm32(R & 31)) : R;
        voffA[i] = (unsigned)(R * K + C) * 2u; voffB[i] = (unsigned)(Rb * K + C) * 2u; }
    const size_t kstep = (size_t)(BK * 2);
    const size_t hstep = (size_t)HALF * K * 2;
    const size_t tstep = 2 * hstep;
    const unsigned ldsw = (unsigned)wid * 1024u;
    const int aoff = lds_byte(wr * 64 + fr, fq * 8), boff = lds_byte(wc * 32 + fr, fq * 8);
#define PG8_SA(b, h) (((b) * 2 + (h)) * HTB)
#define PG8_SB(b, h) ((4 + (b) * 2 + (h)) * HTB)
#define PG8_STAGE(bufoff, gbase, voff) do { _Pragma("unroll") for (int _i = 0; _i < 2; ++_i) { unsigned _vo = (voff)[_i]; asm volatile("" : "+v"(_vo));   \
        __builtin_amdgcn_global_load_lds((const unsigned*)((const char*)(gbase) + _vo), (PG8_LAS unsigned*)(lds + (bufoff) + ldsw + _i * 8192), 16, 0, 0); } } while (0)
#define PG8_LDA(dst, b, h) do { _Pragma("unroll") for (int m = 0; m < 4; ++m) _Pragma("unroll") for (int k = 0; k < 2; ++k) dst[m][k] = *(const PG8_LAS bf16x8*)(lds + PG8_SA(b, h) + aoff + m * 2048 + k * 1024); } while (0)
#define PG8_LDB(dst, b, h) do { _Pragma("unroll") for (int n = 0; n < 2; ++n) _Pragma("unroll") for (int k = 0; k < 2; ++k) dst[n][k] = *(const PG8_LAS bf16x8*)(lds + PG8_SB(b, h) + boff + n * 2048 + k * 1024); } while (0)
#define PG8_MMA(ai, bj, At, Bt) do { __builtin_amdgcn_s_setprio(1); _Pragma("unroll") for (int m = 0; m < 4; ++m) _Pragma("unroll") for (int n = 0; n < 2; ++n) _Pragma("unroll") for (int k = 0; k < 2; ++k) \
        acc[ai][bj][m][n] = __builtin_amdgcn_mfma_f32_16x16x32_bf16(Bt[n][k], At[m][k], acc[ai][bj][m][n], 0, 0, 0); __builtin_amdgcn_s_setprio(0); } while (0)
#define PG8_WAIT_V(n) asm volatile("s_waitcnt vmcnt(" #n ")" ::: "memory")
#define PG8_WAIT_L(n) asm volatile("s_waitcnt lgkmcnt(" #n ")" ::: "memory")
#define PG8_BAR __builtin_amdgcn_s_barrier()
#define PG8_SCHED __builtin_amdgcn_sched_barrier(0)
    Unit cur, nxt; int ui = 0;
    if (!S.next(0, cur)) return;
    f32x4 acc[2][2][4][2];
#pragma unroll
    for (int a = 0; a < 2; ++a)
#pragma unroll
        for (int b = 0; b < 2; ++b)
#pragma unroll
            for (int m = 0; m < 4; ++m)
#pragma unroll
                for (int n = 0; n < 2; ++n) acc[a][b][m][n] = (f32x4){0.f, 0.f, 0.f, 0.f};
    bf16x8 At[4][2], B0[2][2], B1[2][2];
    const char* cA = (const char*)g.A + (size_t)cur.pm * tstep; const char* cB = (const char*)g.Bt + (size_t)cur.pn * tstep;
    S.a_ready(cur);
    if constexpr (SP2) {
        PG8_STAGE(PG8_SB(0, 0), cB, voffB); PG8_STAGE(PG8_SB(0, 1), cB + hstep, voffB); PG8_STAGE(PG8_SA(0, 0), cA, voffA); PG8_STAGE(PG8_SA(0, 1), cA + hstep, voffA);
        if (wr == 1) PG8_BAR;
        PG8_WAIT_V(2); PG8_BAR;
        PG8_STAGE(PG8_SB(1, 0), cB + kstep, voffB); PG8_STAGE(PG8_SA(1, 0), cA + kstep, voffA); PG8_STAGE(PG8_SB(1, 1), cB + hstep + kstep, voffB);
        PG8_WAIT_V(6); PG8_BAR;
    } else {
        PG8_STAGE(PG8_SB(0, 0), cB, voffB); PG8_STAGE(PG8_SA(0, 0), cA, voffA); PG8_STAGE(PG8_SB(0, 1), cB + hstep, voffB); PG8_STAGE(PG8_SA(0, 1), cA + hstep, voffA);
        if (wr == 1) PG8_BAR;
        PG8_WAIT_V(4); PG8_BAR;
        PG8_STAGE(PG8_SB(1, 0), cB + kstep, voffB); PG8_STAGE(PG8_SA(1, 0), cA + kstep, voffA); PG8_STAGE(PG8_SB(1, 1), cB + hstep + kstep, voffB);
        PG8_WAIT_V(6); PG8_BAR;
    }
    for (;;) {
        const bool has_next = S.next(ui + 1, nxt);
        const char* nA = has_next ? (const char*)g.A + (size_t)nxt.pm * tstep : cA; const char* nB = has_next ? (const char*)g.Bt + (size_t)nxt.pn * tstep : cB;
        for (int t = 0; t < nt; t += 2) {
            const bool last = (t == nt - 2);
            const char* a1 = cA + (size_t)(t + 1) * kstep;
            const char* a2 = last ? nA : cA + (size_t)(t + 2) * kstep; const char* b2 = last ? nB : cB + (size_t)(t + 2) * kstep;
            const char* a3 = a2 + kstep; const char* b3 = b2 + kstep;
            if (last && has_next) S.a_ready(nxt);
            if constexpr (SP2) {
            PG8_LDB(B0, 0, 0); PG8_LDB(B1, 0, 1); PG8_SCHED; PG8_LDA(At, 0, 0); PG8_STAGE(PG8_SA(1, 1), a1 + hstep, voffA);
            PG8_WAIT_V(8); PG8_WAIT_L(0); PG8_BAR; PG8_MMA(0, 0, At, B0); PG8_MMA(0, 1, At, B1); PG8_BAR; PG8_SCHED;
            PG8_LDA(At, 0, 1); PG8_STAGE(PG8_SB(0, 0), b2, voffB); PG8_STAGE(PG8_SB(0, 1), b2 + hstep, voffB); PG8_STAGE(PG8_SA(0, 0), a2, voffA);
            PG8_WAIT_V(8); PG8_WAIT_L(0); PG8_BAR; PG8_MMA(1, 0, At, B0); PG8_MMA(1, 1, At, B1); PG8_BAR; PG8_SCHED;
            PG8_LDB(B0, 1, 0); PG8_LDB(B1, 1, 1); PG8_SCHED; PG8_LDA(At, 1, 0); PG8_STAGE(PG8_SA(0, 1), a2 + hstep, voffA);
            PG8_WAIT_V(8); PG8_WAIT_L(0); PG8_BAR; PG8_MMA(0, 0, At, B0); PG8_MMA(0, 1, At, B1); PG8_BAR; PG8_SCHED;
            PG8_LDA(At, 1, 1); PG8_STAGE(PG8_SB(1, 0), b3, voffB); PG8_STAGE(PG8_SB(1, 1), b3 + hstep, voffB); PG8_STAGE(PG8_SA(1, 0), a3, voffA);
            PG8_WAIT_V(8); PG8_WAIT_L(0); PG8_BAR; PG8_MMA(1, 0, At, B0); PG8_MMA(1, 1, At, B1); PG8_BAR; PG8_SCHED;
            } else {
            PG8_LDB(B0, 0, 0); PG8_SCHED; PG8_LDA(At, 0, 0); PG8_STAGE(PG8_SA(1, 1), a1 + hstep, voffA);
            PG8_WAIT_L(8); PG8_BAR; PG8_WAIT_L(0); PG8_MMA(0, 0, At, B0); PG8_BAR; PG8_SCHED;
            PG8_LDB(B1, 0, 1); PG8_STAGE(PG8_SB(0, 0), b2, voffB);
            PG8_BAR; PG8_WAIT_L(0); PG8_MMA(0, 1, At, B1); PG8_BAR;
            PG8_LDA(At, 0, 1); PG8_STAGE(PG8_SA(0, 0), a2, voffA);
            PG8_BAR; PG8_WAIT_L(0); PG8_MMA(1, 0, At, B0); PG8_BAR; PG8_SCHED;
            PG8_STAGE(PG8_SB(0, 1), b2 + hstep, voffB);
            PG8_WAIT_V(6); PG8_BAR; PG8_MMA(1, 1, At, B1); PG8_BAR;
            PG8_LDB(B0, 1, 0); PG8_SCHED; PG8_LDA(At, 1, 0); PG8_STAGE(PG8_SA(0, 1), a2 + hstep, voffA);
            PG8_WAIT_L(8); PG8_BAR; PG8_WAIT_L(0); PG8_MMA(0, 0, At, B0); PG8_BAR; PG8_SCHED;
            PG8_LDB(B1, 1, 1); PG8_STAGE(PG8_SB(1, 0), b3, voffB);
            PG8_BAR; PG8_WAIT_L(0); PG8_MMA(0, 1, At, B1); PG8_BAR;
            PG8_LDA(At, 1, 1); PG8_STAGE(PG8_SA(1, 0), a3, voffA);
            PG8_BAR; PG8_WAIT_L(0); PG8_MMA(1, 0, At, B0); PG8_BAR; PG8_SCHED;
            PG8_STAGE(PG8_SB(1, 1), b3 + hstep, voffB);
            PG8_WAIT_V(6); PG8_BAR; PG8_MMA(1, 1, At, B1); PG8_BAR;
            }
        }
        if constexpr (ALIGN_EPI) { if (wr == 0) PG8_BAR; }
        if constexpr (!Epi::AFTER_DRAIN) { E(acc, cur, wr, wc, fr, fq); S.done(cur); }
        if (!has_next) break;
#pragma unroll
        for (int a = 0; a < 2; ++a)
#pragma unroll
            for (int b = 0; b < 2; ++b)
#pragma unroll
                for (int m = 0; m < 4; ++m)
#pragma unroll
                    for (int n = 0; n < 2; ++n) acc[a][b][m][n] = (f32x4){0.f, 0.f, 0.f, 0.f};
        cur = nxt; cA = nA; cB = nB; ++ui;
        if constexpr (ALIGN_EPI) { if (wr == 1) PG8_BAR; }
    }
    PG8_WAIT_V(0);
    if constexpr (!ALIGN_EPI) { if (wr == 0) PG8_BAR; }
    PG8_BAR;
    if constexpr (Epi::AFTER_DRAIN) { E.fused(acc, cur, wr, wc, fr, fq, lds, wid, lane); S.done(cur); }
#undef PG8_SA
#undef PG8_SB
#undef PG8_STAGE
#undef PG8_LDA
#undef PG8_LDB
#undef PG8_MMA
#undef PG8_WAIT_V
#undef PG8_WAIT_L
#undef PG8_BAR
#undef PG8_SCHED
}
struct EpiF32Clip {
    static constexpr bool PERM = false, AFTER_DRAIN = false;
    float* O; int ldc, Mv, Nv;
    __device__ __forceinline__ void operator()(const f32x4 (&acc)[2][2][4][2], const Unit& u, int wr, int wc, int fr, int fq) const {
        { int l_; asm volatile("v_mbcnt_lo_u32_b32 %0, -1, 0\n\tv_mbcnt_hi_u32_b32 %0, -1, %0" : "=v"(l_)); fr = l_ & 15; fq = l_ >> 4; }
#pragma unroll
        for (int ai = 0; ai < 2; ++ai)
#pragma unroll
            for (int m = 0; m < 4; ++m) { const int row = u.pm * BM + ai * HALF + wr * 64 + m * 16 + fr; if (row >= Mv) continue;
#pragma unroll
                for (int bj = 0; bj < 2; ++bj)
#pragma unroll
                    for (int n = 0; n < 2; ++n) { const int col = u.pn * BM + bj * HALF + wc * 32 + n * 16 + 4 * fq; if (col < Nv) *(f32x4*)(O + (size_t)row * ldc + col) = acc[ai][bj][m][n]; } }
    }
};
struct EpiProj {
    static constexpr bool PERM = false, AFTER_DRAIN = false;
    bf16_t* QA; float* ssq; float* ckv_p; float* ckv_s; float* KR; bf16_t* ZA; bf16_t* ZS; bf16_t* XB; float* conv_p; float* conv_s; float* DT;
    __device__ __forceinline__ void operator()(const f32x4 (&acc)[2][2][4][2], const Unit& u, int wr, int wc, int fr, int fq) const {
        { int l_; asm volatile("v_mbcnt_lo_u32_b32 %0, -1, 0\n\tv_mbcnt_hi_u32_b32 %0, -1, %0" : "=v"(l_)); fr = l_ & 15; fq = l_ >> 4; }
        typedef unsigned u32x2 __attribute__((ext_vector_type(2)));
#pragma unroll
        for (int bj = 0; bj < 2; ++bj) { const int cb = u.pn * BM + bj * HALF + wc * 32;
            const int reg = cb < 384 ? 0 : cb < 640 ? 1 : cb < 704 ? 2 : cb < 1728 ? 3 : cb < 2752 ? 4 : cb < 4288 ? 5 : cb < 4304 ? 6 : 7;
            if (reg == 7) continue;
#pragma unroll
            for (int ai = 0; ai < 2; ++ai)
#pragma unroll
                for (int m = 0; m < 4; ++m) { const int row = u.pm * BM + ai * HALF + wr * 64 + m * 16 + fr; const bool rok = row < 16512; float ss = 0.f;
#pragma unroll
                    for (int n = 0; n < 2; ++n) { const int c = cb + n * 16 + 4 * fq; const f32x4 v = acc[ai][bj][m][n];
                        if (reg == 0) { ss += (v[0] * v[0] + v[1] * v[1]) + (v[2] * v[2] + v[3] * v[3]); if (rok) { u32x2 w; w.x = cvt_pk_bf16(v[0], v[1]); w.y = cvt_pk_bf16(v[2], v[3]); *(u32x2*)(QA + (size_t)row * 384 + c) = w; } }
                        else if (reg == 1) { if (rok) *(f32x4*)((row < 16384 ? ckv_p + (size_t)row * 256 : ckv_s + (size_t)(row - 16384) * 256) + (c - 384)) = v; }
                        else if (reg == 2) { if (rok) *(f32x4*)(KR + (size_t)row * 64 + (c - 640)) = v; }
                        else if (reg == 3 || reg == 4) { if (rok) { f32x4 g;
#pragma unroll
                                for (int e = 0; e < 4; ++e) g[e] = v[e] / (1.0f + __expf(-v[e]));
                                u32x2 w; w.x = cvt_pk_bf16(g[0], g[1]); w.y = cvt_pk_bf16(g[2], g[3]);
                                *(u32x2*)((reg == 3 ? ZA + (size_t)row * 1024 + (c - 704) : ZS + (size_t)row * 1024 + (c - 1728))) = w; } }
                        else if (reg == 5) { if (rok) { u32x2 w; w.x = cvt_pk_bf16(v[0], v[1]); w.y = cvt_pk_bf16(v[2], v[3]); *(u32x2*)(XB + (size_t)row * 1536 + (c - 2752)) = w;
                                if (row >= 16384) *(f32x4*)(conv_s + ((size_t)(row - 16384) * 3 + 2) * 1536 + (c - 2752)) = v;
                                else if ((row & 2047) >= 2045) *(f32x4*)(conv_p + ((size_t)(row >> 11) * 3 + ((row & 2047) - 2045)) * 1536 + (c - 2752)) = v; } }
                        else { if (rok && c < 4304) *(f32x4*)(DT + (size_t)row * 16 + (c - 4288)) = v; } }
                    if (reg == 0) { ss += __shfl_xor(ss, 16); ss += __shfl_xor(ss, 32); if (fq == 0 && rok) atomicAdd(ssq + row, ss); }
                    if (m & 1) asm volatile("" ::: "memory"); } }
    }
};
struct EpiQ {
    static constexpr bool PERM = true, AFTER_DRAIN = false;
    bf16_t* QB; const float* ssq; const float* tab; float qscale; int Mv;
    __device__ __forceinline__ void operator()(const f32x4 (&acc)[2][2][4][2], const Unit& u, int wr, int wc, int fr, int fq) const {
        { int l_; asm volatile("v_mbcnt_lo_u32_b32 %0, -1, 0\n\tv_mbcnt_hi_u32_b32 %0, -1, %0" : "=v"(l_)); fr = l_ & 15; fq = l_ >> 4; }
#pragma unroll
        for (int ai = 0; ai < 2; ++ai)
#pragma unroll
            for (int m = 0; m < 4; ++m) { const int row = u.pm * BM + ai * HALF + wr * 64 + m * 16 + fr; if (row >= Mv) continue;
                const float rs = qscale / sqrtf(ssq[row] * (1.f / 384.f) + 1e-6f); const int pidx = row < 16384 ? (row & 2047) : 2048;
#pragma unroll
                for (int bj = 0; bj < 2; ++bj) { const int cg = u.pn * BM + bj * HALF + wc * 32 + 8 * fq, h = cg / 320, cc = cg - h * 320;
                    const f32x4 v0 = acc[ai][bj][m][0] * rs, v1 = acc[ai][bj][m][1] * rs; bf16_t* dst = QB + (size_t)row * 2560 + h * 320;
                    if (cc < 256) { u32x4 w; w.x = cvt_pk_bf16(v0[0], v0[1]); w.y = cvt_pk_bf16(v0[2], v0[3]); w.z = cvt_pk_bf16(v1[0], v1[1]); w.w = cvt_pk_bf16(v1[2], v1[3]); *(u32x4*)(dst + cc) = w; }
                    else { const int j0 = (cc - 256) >> 1; const f32x4 c4 = *(const f32x4*)(tab + pidx * 64 + j0), s4 = *(const f32x4*)(tab + pidx * 64 + 32 + j0);
                        const float a0 = v0[0] * c4[0] - v0[1] * s4[0], b0 = v0[0] * s4[0] + v0[1] * c4[0], a1 = v0[2] * c4[1] - v0[3] * s4[1], b1 = v0[2] * s4[1] + v0[3] * c4[1];
                        const float a2 = v1[0] * c4[2] - v1[1] * s4[2], b2 = v1[0] * s4[2] + v1[1] * c4[2], a3 = v1[2] * c4[3] - v1[3] * s4[3], b3 = v1[2] * s4[3] + v1[3] * c4[3];
                        typedef unsigned u32x2 __attribute__((ext_vector_type(2)));
                        u32x2 wa, wb; wa.x = cvt_pk_bf16(a0, a1); wa.y = cvt_pk_bf16(a2, a3); wb.x = cvt_pk_bf16(b0, b1); wb.y = cvt_pk_bf16(b2, b3);
                        *(u32x2*)(dst + 256 + j0) = wa; *(u32x2*)(dst + 288 + j0) = wb; } }
                asm volatile("" ::: "memory"); }
    }
};
struct EpiOutSsq {
    static constexpr bool PERM = false, AFTER_DRAIN = false;
    float* O; float* ssq; int ldc, Mv;
    __device__ __forceinline__ void operator()(const f32x4 (&acc)[2][2][4][2], const Unit& u, int wr, int wc, int fr, int fq) const {
        { int l_; asm volatile("v_mbcnt_lo_u32_b32 %0, -1, 0\n\tv_mbcnt_hi_u32_b32 %0, -1, %0" : "=v"(l_)); fr = l_ & 15; fq = l_ >> 4; }
#pragma unroll
        for (int ai = 0; ai < 2; ++ai)
#pragma unroll
            for (int m = 0; m < 4; ++m) { const int row = u.pm * BM + ai * HALF + wr * 64 + m * 16 + fr; float s = 0.f;
#pragma unroll
                for (int bj = 0; bj < 2; ++bj)
#pragma unroll
                    for (int n = 0; n < 2; ++n) { const f32x4 v = acc[ai][bj][m][n]; s += (v[0] * v[0] + v[1] * v[1]) + (v[2] * v[2] + v[3] * v[3]);
                        if (row < Mv) *(f32x4*)(O + (size_t)row * ldc + u.pn * BM + bj * HALF + wc * 32 + n * 16 + 4 * fq) = v; }
                s += __shfl_xor(s, 16); s += __shfl_xor(s, 32);
                if (fq == 0 && row < Mv) atomicAdd(ssq + row, s); }
    }
};
}
constexpr int NWAVES = 8;
constexpr int LDS_BYTES = 147456;
constexpr int LDSCTL_OFF = 143360, MISC_OFF = LDSCTL_OFF + 320;
constexpr size_t WS_CTL = 0, CTL_ZERO_BYTES = 1u << 20;
constexpr int CW_BAR = 4096;
constexpr size_t WS_OUTP = (size_t)448 << 20;
struct Args { const void* in[22]; float* out; unsigned char* ws; int ph_lo, ph_hi; };

__global__ void __launch_bounds__(NWAVES * 64, 2) mega_fwd(Args args) {
    extern __shared__ __attribute__((aligned(16))) unsigned char lds[];
    LAS unsigned char* L = (LAS unsigned char*)lds;
    for (int u = threadIdx.x; u < (LDS_BYTES - LDSCTL_OFF) / 4; u += NWAVES * 64) ((LAS unsigned*)(L + LDSCTL_OFF))[u] = 0u;
    __syncthreads();
    unsigned* ctl = (unsigned*)(args.ws + WS_CTL);
    XcdBarrier bar = xcd_barrier_post(ctl + CW_BAR, (volatile LAS unsigned*)(L + MISC_OFF) + 8);
    const int lo = args.ph_lo, hi = args.ph_hi;
#define IN(k) (lo <= (k) && (k) < hi)
#define SEAM(k) do { if (IN(k) && IN((k) + 1)) xcd_barrier(bar); } while (0)
    using namespace nv;
    const float* x_p = (const float*)args.in[0]; const float* x_s = (const float*)args.in[1]; const float* cache_ckv = (const float*)args.in[2]; const float* cache_kr = (const float*)args.in[3];
    const float* state_conv = (const float*)args.in[4]; const float* state_ssm = (const float*)args.in[5]; const int* page_table = (const int*)args.in[6];
    const float* norm_pre = (const float*)args.in[7]; const float* w_in = (const float*)args.in[8]; const float* q_a_norm = (const float*)args.in[9]; const float* w_q_b = (const float*)args.in[10];
    const float* kv_a_norm = (const float*)args.in[11]; const float* w_uk = (const float*)args.in[12]; const float* w_uv = (const float*)args.in[13]; const float* conv_w = (const float*)args.in[14];
    const float* conv_b = (const float*)args.in[15]; const float* dt_bias = (const float*)args.in[16]; const float* a_log = (const float*)args.in[17]; const float* d_skip = (const float*)args.in[18];
    const float* ssm_norm = (const float*)args.in[19]; const float* w_out = (const float*)args.in[20]; const float* norm_post = (const float*)args.in[21];
    float* out = args.out;
    float* y_p = out; float* y_s = y_p + (size_t)NTOK * 1024; float* ckv_p = y_s + (size_t)DEC * 1024; float* kr_p = ckv_p + (size_t)NTOK * 256; float* conv_p = kr_p + (size_t)NTOK * 64;
    float* ssm_p = conv_p + (size_t)BATCH * 3 * CONVD; float* ckv_s = ssm_p + (size_t)BATCH * 16 * 64 * 128; float* kr_s = ckv_s + (size_t)DEC * 256; float* conv_s = kr_s + (size_t)DEC * 64;
    float* ssm_s = conv_s + (size_t)DEC * 3 * CONVD;
    unsigned char* ws = args.ws;
    mk::bf16* WIN = (mk::bf16*)(ws + mk::WS_WIN); mk::bf16* XN = (mk::bf16*)(ws + mk::WS_XN); mk::bf16* WQ = (mk::bf16*)(ws + mk::WS_WQ); float* TAB = (float*)(ws + mk::WS_TAB);
    mk::bf16* QA = (mk::bf16*)(ws + mk::WS_QA); mk::bf16* KB = (mk::bf16*)(ws + mk::WS_KB); float* DTV = (float*)(ws + mk::WS_DTV); mk::bf16* QB = (mk::bf16*)(ws + mk::WS_QB);
    mk::bf16* XACT = (mk::bf16*)(ws + mk::WS_XACT); mk::bf16* WOUT = (mk::bf16*)(ws + mk::WS_WOUT); mk::bf16* MIXB = (mk::bf16*)(ws + mk::WS_MIX); mk::bf16* WUVF = (mk::bf16*)(ws + at::WS_WUVF);
    float* KRR = (float*)(ws + mk::WS_KRR); float* DTR = (float*)(ws + mk::WS_DTR); mk::bf16* XBR = (mk::bf16*)(ws + mk::WS_XBR); mk::bf16* ZA = (mk::bf16*)(ws + mk::WS_ZA); mk::bf16* ZS = (mk::bf16*)(ws + mk::WS_ZS);
    float* SSQ = (float*)(ws + mk::CTL_SSQ); float* SSQ2 = (float*)(ws + mk::CTL_SSQ2); float* SSQG = (float*)(ws + mk::CTL_SSQG); float* OUTP = (float*)(ws + WS_OUTP);
    const int wave_s = __builtin_amdgcn_readfirstlane(threadIdx.x >> 6);
#define TID() ({ int l_; asm volatile("v_mbcnt_lo_u32_b32 %0, -1, 0\n\tv_mbcnt_hi_u32_b32 %0, -1, %0" : "=v"(l_)); wave_s * 64 + l_; })
    const int gw = blockIdx.x * NWAVES + wave_s, NGW = gridDim.x * NWAVES;

    if (IN(0)) {
        const int lane = TID() & 63; LAS float* scr = (LAS float*)(L + wave_s * 16384);
        for (int it = gw; it < 16 * (mk::N1P / 32); it += NGW) mk::p0_transpose_item(w_in, 1024, NPROJ, norm_pre, 0, WIN, 0, scr, it, mk::N1P / 32, lane);
        for (int it = gw; it < 32 * 32; it += NGW) mk::p0_transpose_item(w_out, 2048, 1024, ssm_norm, 1024, WOUT, 0, scr, it, 32, lane);
        for (int it = gw; it < 512; it += NGW) at::wuvf_item(w_uv, WUVF, it, lane);
        for (int it = gw; it < 2560; it += NGW) mk::wq_item(w_q_b, w_uk, q_a_norm, WQ, it, lane);
        for (int it = blockIdx.x * 512 + TID(); it < 2049 * 32; it += gridDim.x * 512) mk::tab_item(TAB, it);
        for (int m = gw; m < mk::MP; m += NGW) mk::xn_row(m < NTOK ? x_p + (size_t)m * 1024 : (m < MT ? x_s + (size_t)(m - NTOK) * 1024 : nullptr), XN + (size_t)m * 1024, lane);
    }
    SEAM(0);
    if (IN(1)) {
        pg8::Gemm g{(const pg8::bf16_t*)XN, (const pg8::bf16_t*)WIN, mk::MP, mk::N1P, 1024}; pg8::StaticOrder S; S.init(mk::MP, mk::N1P, gridDim.x, (int)blockIdx.x);
        pg8::EpiProj E{(pg8::bf16_t*)QA, SSQ, ckv_p, ckv_s, KRR, (pg8::bf16_t*)ZA, (pg8::bf16_t*)ZS, (pg8::bf16_t*)XBR, conv_p, conv_s, DTR};
        pg8::gemm_phase<pg8::EpiProj, pg8::StaticOrder, true, true>(L, g, S, E, wave_s);
    }
    SEAM(1);
    if (IN(2)) {
        { const int lane = TID() & 63;
          for (int m = gw; m < MT; m += NGW) mk::p2_row(m, lane, KRR, DTR, XBR, kv_a_norm, TAB, dt_bias, conv_w, conv_b, state_conv, KB, DTV, XACT, ckv_p, ckv_s, kr_p, kr_s, conv_s); }
        pg8::Gemm g{(const pg8::bf16_t*)QA, (const pg8::bf16_t*)WQ, mk::MP, 2560, 384}; pg8::StaticOrder S; S.init(mk::MP, 2560, gridDim.x, (int)blockIdx.x);
        pg8::EpiQ E{(pg8::bf16_t*)QB, SSQ, TAB, mk::QSCALE, MT};
        pg8::gemm_phase<pg8::EpiQ, pg8::StaticOrder, true, true>(L, g, S, E, wave_s);
    }
    SEAM(2);
    if (IN(3)) {
        __syncthreads();
        sd::ssd_phase(L, XACT, DTV, a_log, d_skip, ZS, MIXB, SSQG, ssm_p, wave_s, TID() & 63);
        __syncthreads();
        at::attn_phase(L, QB, KB, WUVF, ZA, MIXB, wave_s, TID() & 63);
        __syncthreads();
        dc::dec_phase(L, QB, KB, cache_ckv, cache_kr, page_table, ws, w_uv, ZA, MIXB, wave_s, TID() & 63);
        __syncthreads();
        sd::ssd_dec_phase(L, XACT, DTV, a_log, d_skip, ZS, state_ssm, MIXB, ssm_s, wave_s, TID() & 63);
    }
    SEAM(3);
    if (IN(4)) {
        sd::ssd_norm_rows(MIXB, SSQG, gw, NGW, TID() & 63);
        for (size_t i = (size_t)blockIdx.x * 512 + TID(); i < (size_t)(mk::MP - MT) * 1024; i += (size_t)gridDim.x * 512) ((unsigned*)MIXB)[(size_t)MT * 1024 + i] = 0u;
    }
    SEAM(4);
    if (IN(5)) {
        pg8::Gemm g{(const pg8::bf16_t*)MIXB, (const pg8::bf16_t*)WOUT, mk::MP, 1024, 2048}; pg8::StaticOrder S; S.init(mk::MP, 1024, gridDim.x, (int)blockIdx.x);
        pg8::EpiOutSsq E{OUTP, SSQ2, 1024, MT};
        pg8::gemm_phase<pg8::EpiOutSsq, pg8::StaticOrder, true, true>(L, g, S, E, wave_s);
    }
    SEAM(5);
    if (IN(6)) {
        const int lane = TID() & 63;
        for (int m = gw; m < MT; m += NGW) { const float rstd = 1.0f / sqrtf(SSQ2[m] * (1.f / 1024.f) + EPS);
            const float* xr = m < NTOK ? x_p + (size_t)m * 1024 : x_s + (size_t)(m - NTOK) * 1024; float* yr = m < NTOK ? y_p + (size_t)m * 1024 : y_s + (size_t)(m - NTOK) * 1024;
#pragma unroll
            for (int jj = 0; jj < 4; ++jj) { const int c = 4 * lane + 256 * jj; const mk::f32x4 o = *(const mk::f32x4*)(OUTP + (size_t)m * 1024 + c), xx = *(const mk::f32x4*)(xr + c), w = *(const mk::f32x4*)(norm_post + c);
                *(mk::f32x4*)(yr + c) = xx + o * rstd * w; } }
    }
#undef IN
#undef SEAM
}
constexpr int N_PHASES = 7;
#ifndef MK_PER_PHASE
#define MK_PER_PHASE 0
#endif
extern "C" void kernel_launch(void* const* d_in, const int* in_sizes, int n_in, void* d_out, int out_size, void* d_ws, size_t ws_size, hipStream_t stream) {
    static int grid = 0;
    if (grid == 0) {
        int dev = 0, cus = 0;
        if (hipGetDevice(&dev) != hipSuccess || hipDeviceGetAttribute(&cus, hipDeviceAttributeMultiprocessorCount, dev) != hipSuccess) { grid = -1; return; }
        if (hipFuncSetAttribute((const void*)mega_fwd, hipFuncAttributeMaxDynamicSharedMemorySize, LDS_BYTES) != hipSuccess) { fprintf(stderr, "kernel_launch: hipFuncSetAttribute failed\n"); grid = -1; return; }
        int per_cu = 0;
        if (hipOccupancyMaxActiveBlocksPerMultiprocessor(&per_cu, (const void*)mega_fwd, NWAVES * 64, LDS_BYTES) != hipSuccess || per_cu < 1) fprintf(stderr, "kernel_launch: occupancy query says %d\n", per_cu);
        (void)hipGetLastError();
        grid = cus;
    }
    if (grid < 0) return;
    (void)hipMemsetAsync((char*)d_ws + WS_CTL, 0, CTL_ZERO_BYTES, stream);
    Args a{};
    for (int i = 0; i < 22; ++i) a.in[i] = d_in[i];
    a.out = (float*)d_out; a.ws = (unsigned char*)d_ws;
#if MK_PER_PHASE
    for (int p = 0; p < N_PHASES; ++p) { a.ph_lo = p; a.ph_hi = p + 1; hipLaunchKernelGGL(mega_fwd, dim3(grid), dim3(NWAVES * 64), LDS_BYTES, stream, a); }
#else
    a.ph_lo = 0; a.ph_hi = N_PHASES;
    hipLaunchKernelGGL(mega_fwd, dim3(grid), dim3(NWAVES * 64), LDS_BYTES, stream, a);
#endif
}
```

```cpp
#include <hip/hip_runtime.h>
#include <cstdint>
#include <cstdio>
#define GAS __attribute__((address_space(1)))
#define LAS __attribute__((address_space(3)))
#define XB_TMO      128
#define XB_XCNT(j)  (256  + 64 * (j))
#define XB_XSUB(j)  (1280 + 64 * (j))
#define XB_XGEN(j)  (2304 + 64 * (j))
#define XB_TOP      3328
#define XB_TOPGEN   3392
#define XCD_BAR_WORDS 3456
#define XB_SPIN_CAP (1u << 24)

__device__ __forceinline__ unsigned xb_ld(unsigned* p)              { return __hip_atomic_load(p, __ATOMIC_RELAXED, __HIP_MEMORY_SCOPE_AGENT); }
__device__ __forceinline__ unsigned xb_add(unsigned* p, unsigned v) { return __hip_atomic_fetch_add(p, v, __ATOMIC_RELAXED, __HIP_MEMORY_SCOPE_AGENT); }
__device__ __forceinline__ unsigned xb_lane() { unsigned l_; asm volatile("v_mbcnt_lo_u32_b32 %0, -1, 0\n\tv_mbcnt_hi_u32_b32 %0, -1, %0" : "=v"(l_)); return l_; }
__device__ __forceinline__ unsigned xb_xcc_id() { return (unsigned)__builtin_amdgcn_s_getreg((3 << 11) | 20) & 0xFu; }
#define XB_SPIN(cond, bar) do { unsigned _sp = 0; while (cond) { __builtin_amdgcn_s_sleep(1); \
    if ((++_sp & 255u) == 0u) { if (xb_ld(&(bar)[XB_TMO])) break; if (_sp > XB_SPIN_CAP) { atomicAdd(&(bar)[XB_TMO], 1u); break; } } } } while (0)

struct XcdBarrier {
    unsigned* bar; unsigned x; unsigned w0;
    volatile LAS unsigned* st;
};

__device__ __forceinline__ XcdBarrier xcd_barrier_post(unsigned* bar, volatile LAS unsigned* st) {
    XcdBarrier b; b.bar = bar; b.x = xb_xcc_id(); b.st = st; b.w0 = (unsigned)(__builtin_amdgcn_readfirstlane(threadIdx.x >> 6) == 0);
    if (threadIdx.x == 0) (void)xb_add(&bar[XB_XCNT(b.x)], 1u);
    return b;
}
__device__ __forceinline__ void xcd_barrier_complete(unsigned* bar, unsigned x, unsigned& nloc, unsigned& nx) {
    const unsigned G = gridDim.x * gridDim.y * gridDim.z;
    unsigned sum, cnt, mine, sp = 0u;
    for (;;) {
        sum = 0u; cnt = 0u; mine = 0u;
#pragma unroll
        for (unsigned j = 0; j < 16; ++j) { const unsigned c = xb_ld(&bar[XB_XCNT(j)]); sum += c; cnt += (c > 0u) ? 1u : 0u; mine = (j == x) ? c : mine; }
        if (sum == G) break;
        __builtin_amdgcn_s_sleep(1);
        if ((++sp & 255u) == 0u) { if (xb_ld(&bar[XB_TMO])) break; if (sp > XB_SPIN_CAP) { atomicAdd(&bar[XB_TMO], 1u); break; } }
    }
    nloc = mine > 0u ? mine : 1u; nx = cnt > 0u ? cnt : 1u;
}

__device__ __forceinline__ void xcd_barrier(const XcdBarrier& b) {
    asm volatile("s_waitcnt vmcnt(0)" ::: "memory");
    __syncthreads();
    if (b.w0 && xb_lane() == 0u) {
        unsigned* bar = b.bar;
        __builtin_amdgcn_s_waitcnt(0);
        unsigned nloc = b.st[0], nx = b.st[1];
        if (nloc == 0u) { xcd_barrier_complete(bar, b.x, nloc, nx); b.st[0] = nloc; b.st[1] = nx; }
        const unsigned old = xb_add(&bar[XB_XSUB(b.x)], 1u);
        const unsigned gen = old / nloc;
        if (old + 1u == (gen + 1u) * nloc) {
            __builtin_amdgcn_fence(__ATOMIC_RELEASE, "agent");
            asm volatile("s_waitcnt vmcnt(0)" ::: "memory");
            const unsigned og = xb_add(&bar[XB_TOP], 1u);
            const unsigned tg = og / nx;
            if (og + 1u == (tg + 1u) * nx) xb_add(&bar[XB_TOPGEN], 1u);
            else XB_SPIN(xb_ld(&bar[XB_TOPGEN]) == tg, bar);
            __builtin_amdgcn_fence(__ATOMIC_ACQUIRE, "agent");
            xb_add(&bar[XB_XGEN(b.x)], 1u);
            asm volatile("s_waitcnt vmcnt(0)" ::: "memory");
        } else {
            XB_SPIN(xb_ld(&bar[XB_XGEN(b.x)]) == gen, bar);
            __builtin_amdgcn_fence(__ATOMIC_ACQUIRE, "agent");
            asm volatile("s_waitcnt vmcnt(0)" ::: "memory");
        }
    }
    __syncthreads();
}
namespace nv {
constexpr int D_MODEL = 1024, BATCH = 8, SEQ = 2048, DEC = 128, PAST = 8192, PAGE = 128, NPAGES = 64;
constexpr int NTOK = BATCH * SEQ, MT = NTOK + DEC;
constexpr int HEADS = 8, NOPE = 128, ROPE = 64, QRANK = 384, KVR = 256, VH = 128, DATTN = 1024, DSSM = 1024, DMIX = 2048;
constexpr int SH = 16, HD = 64, NG = 2, DSTATE = 128, CONVD = 1536, NPROJ = 4304;
constexpr int C_QA = 0, C_CR = 384, C_KR = 640, C_ZA = 704, C_ZS = 1728, C_XBC = 2752, C_DT = 4288;
constexpr float EPS = 1e-6f;
constexpr int QK = KVR + ROPE;

template <bool TRANSB>
__device__ __forceinline__ void gemm_vb(int vb, int t, float* sh, const float* __restrict__ A, const float* __restrict__ B, float* __restrict__ C, int M, int N, int K,
                                        int lda, int ldb, int ldc, long sA, long sB, long sC, int gx, int gy) {
    float (*As)[65] = (float (*)[65])sh; float (*Bs)[65] = (float (*)[65])(sh + 16 * 65);
    const int bx = vb % gx, by = (vb / gx) % gy, bz = vb / (gx * gy);
    A += sA * bz; B += sB * bz; C += sC * bz;
    const int tx = t & 15, ty = t >> 4, m0 = by * 64, n0 = bx * 64;
    float acc[4][4] = {};
    for (int k0 = 0; k0 < K; k0 += 16) {
        for (int i = t; i < 1024; i += 256) { const int mm = i >> 4, kk = i & 15; const int m = m0 + mm; As[kk][mm] = (m < M) ? A[(long)m * lda + k0 + kk] : 0.f; }
        if (TRANSB) { for (int i = t; i < 1024; i += 256) { const int nn = i >> 4, kk = i & 15; const int n = n0 + nn; Bs[kk][nn] = (n < N) ? B[(long)n * ldb + k0 + kk] : 0.f; } }
        else        { for (int i = t; i < 1024; i += 256) { const int kk = i >> 6, nn = i & 63; const int n = n0 + nn; Bs[kk][nn] = (n < N) ? B[(long)(k0 + kk) * ldb + n] : 0.f; } }
        __syncthreads();
#pragma unroll
        for (int kk = 0; kk < 16; ++kk) {
            float a[4], b[4];
#pragma unroll
            for (int i = 0; i < 4; ++i) { a[i] = As[kk][ty * 4 + i]; b[i] = Bs[kk][tx * 4 + i]; }
#pragma unroll
            for (int i = 0; i < 4; ++i)
#pragma unroll
                for (int j = 0; j < 4; ++j) acc[i][j] += a[i] * b[j];
        }
        __syncthreads();
    }
#pragma unroll
    for (int i = 0; i < 4; ++i) { const int m = m0 + ty * 4 + i; if (m >= M) continue;
#pragma unroll
        for (int j = 0; j < 4; ++j) { const int n = n0 + tx * 4 + j; if (n < N) C[(long)m * ldc + n] = acc[i][j]; } }
}
__device__ __forceinline__ float block_sum256(float v, float* sh, int t) {
    for (int o = 32; o > 0; o >>= 1) v += __shfl_xor(v, o);
    __syncthreads();
    if ((t & 63) == 0) sh[t >> 6] = v;
    __syncthreads();
    return sh[0] + sh[1] + sh[2] + sh[3];
}
__device__ __forceinline__ float block_max256(float v, float* sh, int t) {
    for (int o = 32; o > 0; o >>= 1) v = fmaxf(v, __shfl_xor(v, o));
    __syncthreads();
    if ((t & 63) == 0) sh[t >> 6] = v;
    __syncthreads();
    return fmaxf(fmaxf(sh[0], sh[1]), fmaxf(sh[2], sh[3]));
}
__device__ __forceinline__ void rmsnorm_vb(int vb, int t, float* sh, const float* in, long ld_in, const float* w, float* out, long ld_out, float* out2, long ld_out2, int ncols) {
    const float* r = in + (long)vb * ld_in;
    float s = 0.f; for (int c = t; c < ncols; c += 256) { const float v = r[c]; s += v * v; }
    s = block_sum256(s, sh, t);
    const float rstd = 1.0f / sqrtf(s / (float)ncols + EPS);
    for (int c = t; c < ncols; c += 256) { const float v = r[c] * rstd * w[c]; out[(long)vb * ld_out + c] = v; if (out2) out2[(long)vb * ld_out2 + c] = v; }
}
__device__ __forceinline__ float siluf(float v) { return v / (1.0f + expf(-v)); }
__device__ __forceinline__ int tok_pos(int row) { return row < NTOK ? (row % SEQ) : PAST; }
__device__ __forceinline__ void rope_cs(int pos, int j, float& c, float& s) {
    const double inv = exp(-(double)j / 32.0 * log(10000.0)); const double a = (double)pos * inv; c = (float)cos(a); s = (float)sin(a);
}
__device__ __forceinline__ void rope_q_vb(int vb, int t, const float* q192, float* qcat) {
    const int row = vb, h = t >> 5, j = t & 31;
    float c, s; rope_cs(tok_pos(row), j, c, s);
    const float x1 = q192[(long)row * 1536 + h * 192 + 128 + j], x2 = q192[(long)row * 1536 + h * 192 + 160 + j];
    qcat[((long)row * 8 + h) * QK + 256 + j] = x1 * c - x2 * s; qcat[((long)row * 8 + h) * QK + 288 + j] = x1 * s + x2 * c;
}
__device__ __forceinline__ void rope_k_vb(int vb, int t, const float* proj, float* kcat, float* out_p, float* out_s) {
    const int row = vb * 8 + (t >> 5), j = t & 31; if (row >= MT) return;
    float c, s; rope_cs(tok_pos(row), j, c, s);
    const float x1 = proj[(long)row * NPROJ + C_KR + j], x2 = proj[(long)row * NPROJ + C_KR + 32 + j];
    const float a = x1 * c - x2 * s, b = x1 * s + x2 * c;
    kcat[(long)row * QK + 256 + j] = a; kcat[(long)row * QK + 288 + j] = b;
    float* o = row < NTOK ? out_p + (long)row * 64 : out_s + (long)(row - NTOK) * 64; o[j] = a; o[32 + j] = b;
}
__device__ __forceinline__ void qlat_vb(int vb, int t, float* sh, const float* q192, const float* w_uk, float* qcat) {
    float (*qs)[128] = (float (*)[128])sh;
    const int row = vb;
    for (int i = t; i < 1024; i += 256) qs[i >> 7][i & 127] = q192[(long)row * 1536 + (i >> 7) * 192 + (i & 127)];
    __syncthreads();
    const int r = t;
    for (int h = 0; h < 8; ++h) { const float* w = w_uk + ((long)r * 8 + h) * 128; float a = 0.f; for (int n = 0; n < 128; ++n) a += qs[h][n] * w[n]; qcat[((long)row * 8 + h) * QK + r] = a; }
}
__device__ __forceinline__ void softmax_vb(int vb, int t, float* sh, float* S, float scale) {
    const long rowi = vb; const int s = (int)((rowi % (SEQ * 8)) >> 3); float* r = S + rowi * SEQ;
    float m = -3.0e38f; for (int k = t; k <= s; k += 256) m = fmaxf(m, r[k] * scale);
    m = block_max256(m, sh, t);
    float l = 0.f; for (int k = t; k < SEQ; k += 256) { float e = 0.f; if (k <= s) { e = expf(r[k] * scale - m); l += e; } r[k] = e; }
    l = block_sum256(l, sh, t); const float inv = 1.0f / l;
    for (int k = t; k <= s; k += 256) r[k] *= inv;
}
__device__ __forceinline__ void dec_attn_vb(int vb, int t, float* sh, const float* qcat, const float* kcat, const float* cache_ckv, const float* cache_kr, const int* page_table, float* olat, float scale, float* scratch) {
    float* q = sh + 8;
    const int b = vb >> 3, h = vb & 7, row = NTOK + b;
    float* sc = scratch + (long)vb * 8256;
    __syncthreads();
    for (int i = t; i < QK; i += 256) q[i] = qcat[((long)row * 8 + h) * QK + i];
    __syncthreads();
    const int wv = t >> 6, lane = t & 63;
    for (int k = wv; k <= PAST; k += 4) {
        float a = 0.f;
        if (k < PAST) { const long pg = page_table[b * NPAGES + (k >> 7)]; const float* c = cache_ckv + (pg * PAGE + (k & 127)) * KVR; const float* kr = cache_kr + (pg * PAGE + (k & 127)) * ROPE;
            for (int i = lane; i < KVR; i += 64) a += q[i] * c[i]; a += q[256 + lane] * kr[lane]; }
        else { const float* c = kcat + (long)row * QK; for (int i = lane; i < QK; i += 64) a += q[i] * c[i]; }
        for (int o = 32; o > 0; o >>= 1) a += __shfl_xor(a, o);
        if (lane == 0) sc[k] = a * scale;
    }
    __threadfence_block(); __syncthreads();
    float m = -3.0e38f; for (int k = t; k <= PAST; k += 256) m = fmaxf(m, sc[k]);
    m = block_max256(m, sh, t);
    float l = 0.f; for (int k = t; k <= PAST; k += 256) { const float e = expf(sc[k] - m); sc[k] = e; l += e; }
    l = block_sum256(l, sh, t); __threadfence_block(); __syncthreads();
    const int r = t; float o = 0.f;
    for (int k = 0; k < PAST; ++k) { const long pg = page_table[b * NPAGES + (k >> 7)]; o += sc[k] * cache_ckv[(pg * PAGE + (k & 127)) * KVR + r]; }
    o += sc[PAST] * kcat[(long)row * QK + r];
    olat[((long)row * 8 + h) * KVR + r] = o / l;
}
__device__ __forceinline__ void uv_gate_vb(int vb, int t, float* sh, const float* olat, const float* w_uv, const float* proj, float* mix) {
    const int row = vb >> 2, h = (vb & 3) * 2 + (t >> 7), v = t & 127; float* os = sh + (t >> 7) * 256;
    __syncthreads();
    os[v] = olat[((long)row * 8 + h) * KVR + v]; os[v + 128] = olat[((long)row * 8 + h) * KVR + 128 + v];
    __syncthreads();
    float a = 0.f; for (int r = 0; r < 256; ++r) a += os[r] * w_uv[((long)r * 8 + h) * 128 + v];
    mix[(long)row * DMIX + h * 128 + v] = a * siluf(proj[(long)row * NPROJ + C_ZA + h * 128 + v]);
}
__device__ __forceinline__ void conv_vb(int vb, int t, const float* proj, const float* state_conv, const float* conv_w, const float* conv_b, float* xact, float* out_cp, float* out_cs) {
    const int row = vb;
    for (int c = t; c < CONVD; c += 256) {
        float xp[4];
        if (row < NTOK) { const int s = row % SEQ; for (int k = 0; k < 4; ++k) { const int ss = s + k - 3; xp[k] = ss >= 0 ? proj[(long)(row + k - 3) * NPROJ + C_XBC + c] : 0.f; }
            if (s >= SEQ - 3) out_cp[((long)(row / SEQ) * 3 + (s - (SEQ - 3))) * CONVD + c] = xp[3]; }
        else { const int b = row - NTOK; for (int k = 0; k < 3; ++k) xp[k] = state_conv[((long)b * 3 + k) * CONVD + c]; xp[3] = proj[(long)row * NPROJ + C_XBC + c];
            for (int k = 0; k < 3; ++k) out_cs[((long)b * 3 + k) * CONVD + c] = xp[k + 1]; }
        float a = conv_b[c]; for (int k = 0; k < 4; ++k) a += xp[k] * conv_w[k * CONVD + c];
        xact[(long)row * CONVD + c] = siluf(a);
    }
}
__device__ __forceinline__ void ssd_rec_vb(int vb, int t, const float* xact, const float* proj, const float* dt_bias, const float* a_log, const float* h0, float* y, float* hout, int row0_stride, int row_base, int steps) {
    const int seq = vb >> 4, hd = vb & 15, g = hd >> 3, p = t >> 2, nb = (t & 3) * 32;
    float h[32];
    for (int i = 0; i < 32; ++i) h[i] = h0 ? h0[(((long)seq * 16 + hd) * 64 + p) * 128 + nb + i] : 0.f;
    const float A = -expf(a_log[hd]), dtb = dt_bias[hd];
    for (int tt = 0; tt < steps; ++tt) {
        const long row = row_base + (long)seq * row0_stride + tt;
        const float* xr = xact + row * CONVD;
        float dtr = proj[row * NPROJ + C_DT + hd] + dtb; const float dt = dtr > 20.f ? dtr : log1pf(expf(dtr));
        const float dec = expf(dt * A), xd = xr[hd * 64 + p] * dt;
        const float* Bv = xr + 1024 + g * 128 + nb; const float* Cv = xr + 1280 + g * 128 + nb;
        float acc = 0.f;
#pragma unroll
        for (int i = 0; i < 32; ++i) { h[i] = dec * h[i] + xd * Bv[i]; acc += h[i] * Cv[i]; }
        acc += __shfl_xor(acc, 1); acc += __shfl_xor(acc, 2);
        if ((t & 3) == 0) y[row * DSSM + hd * 64 + p] = acc;
    }
    for (int i = 0; i < 32; ++i) hout[(((long)seq * 16 + hd) * 64 + p) * 128 + nb + i] = h[i];
}
__device__ __forceinline__ void ssd_out_vb(int vb, int t, float* sh, const float* y, const float* xact, const float* proj, const float* d_skip, const float* ssm_norm, float* mix) {
    const int row = vb >> 1, g = vb & 1;
    float v[2]; float s = 0.f;
    for (int i = 0; i < 2; ++i) { const int c = g * 512 + t + i * 256; const int hd = c >> 6;
        const float yy = y[(long)row * DSSM + c] + d_skip[hd] * xact[(long)row * CONVD + c];
        v[i] = yy * siluf(proj[(long)row * NPROJ + C_ZS + c]); s += v[i] * v[i]; }
    s = block_sum256(s, sh, t); const float rstd = 1.0f / sqrtf(s / 512.f + EPS);
    for (int i = 0; i < 2; ++i) { const int c = g * 512 + t + i * 256; mix[(long)row * DMIX + 1024 + c] = v[i] * rstd * (ssm_norm ? ssm_norm[c] : 1.f); }
}
__device__ __forceinline__ void final_vb(int vb, int t, float* sh, const float* outp, const float* xp, const float* xs, const float* norm_post, float* yp, float* ys) {
    const int row = vb; const float* r = outp + (long)row * D_MODEL;
    const float* x = row < NTOK ? xp + (long)row * D_MODEL : xs + (long)(row - NTOK) * D_MODEL; float* o = row < NTOK ? yp + (long)row * D_MODEL : ys + (long)(row - NTOK) * D_MODEL;
    float s = 0.f; for (int c = t; c < D_MODEL; c += 256) s += r[c] * r[c];
    s = block_sum256(s, sh, t); const float rstd = 1.0f / sqrtf(s / 1024.f + EPS);
    for (int c = t; c < D_MODEL; c += 256) o[c] = x[c] + r[c] * rstd * norm_post[c];
}
struct Bufs { float *H, *PROJ, *QN, *Q192, *QCAT, *KCAT, *S, *OLAT, *XACT, *Y, *MIX, *OUTP, *DSC; };
__host__ __device__ inline void carve(unsigned char* base, size_t& off, size_t bytes, float** p) { *p = (float*)(base + off); off += (bytes + 255) & ~(size_t)255; }
__host__ __device__ inline void make_bufs(unsigned char* ws, Bufs& B) {
    size_t off = (size_t)1 << 30;
    carve(ws, off, (size_t)MT * 1024 * 4, &B.H); carve(ws, off, (size_t)MT * NPROJ * 4, &B.PROJ); carve(ws, off, (size_t)MT * 384 * 4, &B.QN); carve(ws, off, (size_t)MT * 1536 * 4, &B.Q192);
    carve(ws, off, (size_t)MT * 8 * QK * 4, &B.QCAT); carve(ws, off, (size_t)MT * QK * 4, &B.KCAT); carve(ws, off, (size_t)BATCH * SEQ * 8 * SEQ * 4, &B.S); carve(ws, off, (size_t)MT * 8 * KVR * 4, &B.OLAT);
    carve(ws, off, (size_t)MT * CONVD * 4, &B.XACT); carve(ws, off, (size_t)MT * DSSM * 4, &B.Y); carve(ws, off, (size_t)MT * DMIX * 4, &B.MIX); carve(ws, off, (size_t)MT * 1024 * 4, &B.OUTP);
    carve(ws, off, (size_t)DEC * 8 * 8256 * 4, &B.DSC);
}
}
namespace mk {
using namespace nv;
typedef unsigned short bf16;
typedef unsigned v4u __attribute__((ext_vector_type(4)));
typedef unsigned v2u __attribute__((ext_vector_type(2)));
typedef float f32x4 __attribute__((ext_vector_type(4)));
typedef float f32x2 __attribute__((ext_vector_type(2)));
typedef short bf16x8 __attribute__((ext_vector_type(8)));
constexpr int MP = 16640;
constexpr int N1P = 4352;
#define LDS_WAIT() asm volatile("s_waitcnt lgkmcnt(0)" ::: "memory")
#define VM_WAIT() asm volatile("s_waitcnt vmcnt(0)" ::: "memory")
__device__ __forceinline__ unsigned f2bf(float f) { unsigned u = __builtin_bit_cast(unsigned, f); return (u + 0x7fffu + ((u >> 16) & 1u)) >> 16; }
__device__ __forceinline__ unsigned pk2(float lo, float hi) { return f2bf(lo) | (f2bf(hi) << 16); }
__device__ __forceinline__ float bf2f(unsigned short b) { return __builtin_bit_cast(float, (unsigned)b << 16); }
__device__ __forceinline__ float wave_sum(float v) {
#pragma unroll
    for (int o = 1; o < 64; o <<= 1) v += __shfl_xor(v, o);
    return v;
}
constexpr size_t MiB = 1u << 20;
constexpr size_t WS_WIN = 2 * MiB;
constexpr size_t WS_XN = 16 * MiB;
__device__ __forceinline__ void p0_transpose_item(const float* W, int K, int N, const float* kscale, int ksoff, bf16* WT, int row_off, LAS float* scr, int item, int nblk, int lane) {
    const int kb = item / nblk, nb = item % nblk, k0 = 64 * kb, n0 = 32 * nb;
#pragma unroll 8
    for (int i = 0; i < 32; ++i) { const int kk = 2 * i + (lane >> 5); const int n = n0 + (lane & 31);
        float v = (n < N) ? W[(size_t)(k0 + kk) * N + n] : 0.f; if (kscale && k0 + kk >= ksoff) v *= kscale[k0 + kk - ksoff]; scr[kk * 33 + (lane & 31)] = v; }
    LDS_WAIT(); asm volatile("" ::: "memory");
    const int c = lane & 7;
#pragma unroll
    for (int j = 0; j < 4; ++j) { const int n = (lane >> 3) + 8 * j; const LAS float* s = scr + (8 * c) * 33 + n;
        v4u o; o.x = pk2(s[0 * 33], s[1 * 33]); o.y = pk2(s[2 * 33], s[3 * 33]); o.z = pk2(s[4 * 33], s[5 * 33]); o.w = pk2(s[6 * 33], s[7 * 33]);
        *(GAS v4u*)(WT + (size_t)(row_off + n0 + n) * K + k0 + 8 * c) = o; }
    LDS_WAIT(); asm volatile("" ::: "memory");
}
__device__ __forceinline__ void xn_row(const float* xrow, bf16* orow, int lane) {
    GAS unsigned long long* o8 = (GAS unsigned long long*)orow + lane;
    if (!xrow) {
#pragma unroll
        for (int j = 0; j < 4; ++j) o8[64 * j] = 0ull;
        return; }
    const GAS f32x4* xr = (const GAS f32x4*)xrow + lane;
    f32x4 v[4]; float s = 0.f;
#pragma unroll
    for (int j = 0; j < 4; ++j) { v[j] = xr[64 * j]; s += (v[j].x * v[j].x + v[j].y * v[j].y) + (v[j].z * v[j].z + v[j].w * v[j].w); }
    const float rstd = 1.f / sqrtf(wave_sum(s) * (1.f / 1024.f) + EPS);
#pragma unroll
    for (int j = 0; j < 4; ++j) o8[64 * j] = (unsigned long long)pk2(v[j].x * rstd, v[j].y * rstd) | ((unsigned long long)pk2(v[j].z * rstd, v[j].w * rstd) << 32);
}
__device__ __forceinline__ void xn_row2(const float* xa, const float* xb, bf16* oa, bf16* ob, int lane) {
    const GAS f32x4* ra = (const GAS f32x4*)xa + lane; const GAS f32x4* rb = (const GAS f32x4*)xb + lane;
    f32x4 va[4], vb[4]; float sa = 0.f, sb = 0.f;
#pragma unroll
    for (int j = 0; j < 4; ++j) { va[j] = ra[64 * j]; vb[j] = rb[64 * j]; }
#pragma unroll
    for (int j = 0; j < 4; ++j) { sa += (va[j].x * va[j].x + va[j].y * va[j].y) + (va[j].z * va[j].z + va[j].w * va[j].w); sb += (vb[j].x * vb[j].x + vb[j].y * vb[j].y) + (vb[j].z * vb[j].z + vb[j].w * vb[j].w); }
    const float ia = 1.f / sqrtf(wave_sum(sa) * (1.f / 1024.f) + EPS), ib = 1.f / sqrtf(wave_sum(sb) * (1.f / 1024.f) + EPS);
    GAS unsigned long long* pa = (GAS unsigned long long*)oa + lane; GAS unsigned long long* pb = (GAS unsigned long long*)ob + lane;
#pragma unroll
    for (int j = 0; j < 4; ++j) { pa[64 * j] = (unsigned long long)pk2(va[j].x * ia, va[j].y * ia) | ((unsigned long long)pk2(va[j].z * ia, va[j].w * ia) << 32);
                                  pb[64 * j] = (unsigned long long)pk2(vb[j].x * ib, vb[j].y * ib) | ((unsigned long long)pk2(vb[j].z * ib, vb[j].w * ib) << 32); }
}
}
namespace mk {
constexpr size_t WS_WQ = 12 * MiB;
constexpr size_t WS_TAB = 14 * MiB + 512 * 1024;
constexpr size_t WS_QA = 50 * MiB;
constexpr size_t WS_KB = 64 * MiB;
constexpr size_t WS_DTV = 76 * MiB;
constexpr size_t WS_QB = 80 * MiB;
constexpr size_t WS_XACT = 164 * MiB;
constexpr size_t WS_WOUT = 216 * MiB;
constexpr size_t WS_MIX = 224 * MiB;
constexpr size_t CTL_SSQ2 = 65536 + 131072;
constexpr size_t WS_KRR = 304 * MiB;
constexpr size_t WS_DTR = 296 * MiB;
constexpr size_t WS_XBR = 320 * MiB;
constexpr size_t WS_ZA = 372 * MiB;
constexpr size_t WS_ZS = 408 * MiB;
constexpr size_t CTL_SSQG = 65536 + 3 * 131072;
constexpr size_t CTL_SSQ = 65536;
constexpr float QSCALE = 0.07216878364870322f * 1.4426950408889634f;
__device__ __forceinline__ void tab_item(float* tab, int idx) { const int p = idx >> 5, j = idx & 31; float c, s; rope_cs(p < 2048 ? p : PAST, j, c, s); tab[p * 64 + j] = c; tab[p * 64 + 32 + j] = s; }
__device__ __forceinline__ void wq_lat_item(const float* w_q_b, const float* w_uk, const float* q_a_norm, bf16* WQ, int item, int lane) {
    typedef float f32x16_t __attribute__((ext_vector_type(16)));
    const int rt = item & 7, kt = (item >> 3) % 12, h = item / 96, i31 = lane & 31, half = lane >> 5;
    const f32x4* ap = (const f32x4*)(w_q_b + (size_t)(32 * kt + i31) * 1536 + h * 192 + 4 * half);
    const f32x4* bp = (const f32x4*)(w_uk + ((size_t)(32 * rt + i31) * 8 + h) * 128 + 4 * half);
    f32x16_t acc = (f32x16_t){};
#pragma unroll 4
    for (int j = 0; j < 16; ++j) { const f32x4 a = ap[2 * j], bq = bp[2 * j];
        acc = __builtin_amdgcn_mfma_f32_32x32x2f32(a.x, bq.x, acc, 0, 0, 0); acc = __builtin_amdgcn_mfma_f32_32x32x2f32(a.y, bq.y, acc, 0, 0, 0);
        acc = __builtin_amdgcn_mfma_f32_32x32x2f32(a.z, bq.z, acc, 0, 0, 0); acc = __builtin_amdgcn_mfma_f32_32x32x2f32(a.w, bq.w, acc, 0, 0, 0); }
    bf16* dst = WQ + (size_t)(h * 320 + 32 * rt + i31) * 384 + 32 * kt + 4 * half;
#pragma unroll
    for (int g = 0; g < 4; ++g) { const f32x4 nq = *(const f32x4*)(q_a_norm + 32 * kt + 8 * g + 4 * half);
        v2u w; w.x = pk2(acc[4 * g] * nq.x, acc[4 * g + 1] * nq.y); w.y = pk2(acc[4 * g + 2] * nq.z, acc[4 * g + 3] * nq.w); *(v2u*)(dst + 8 * g) = w; }
}
__device__ __forceinline__ void wq_rope_item(const float* w_q_b, const float* q_a_norm, bf16* WQ, int item, int lane) {
    const int h = item >> 6, cc = item & 63, e = cc & 1, j = cc >> 1;
#pragma unroll
    for (int i = 0; i < 6; ++i) { const int k = lane + 64 * i; WQ[(size_t)(h * 320 + 256 + cc) * 384 + k] = (bf16)f2bf(w_q_b[(size_t)k * 1536 + h * 192 + 128 + 32 * e + j] * q_a_norm[k]); }
}
__device__ __forceinline__ float softplusf(float v) { return v > 20.f ? v : log1pf(expf(v)); }
__device__ __forceinline__ float silu_fast(float v) { return v / (1.0f + __expf(-v)); }
__device__ __forceinline__ void p2_row(int row, int lane, const float* KRR, const float* DTR, const bf16* XBR, const float* kv_a_norm, const float* tab, const float* dt_bias, const float* conv_w, const float* conv_b, const float* state_conv,
                                       bf16* KB, float* DTV, bf16* XACT, float* ckv_p, float* ckv_s, float* kr_p, float* kr_s, float* conv_s) {
    const int pidx = row < NTOK ? (row % SEQ) : 2048;
    {
        float* dst = row < NTOK ? ckv_p + (size_t)row * 256 : ckv_s + (size_t)(row - NTOK) * 256;
        const f32x4 v = *(const f32x4*)(dst + 4 * lane); const float ss = wave_sum((v.x * v.x + v.y * v.y) + (v.z * v.z + v.w * v.w));
        const float rstd = 1.0f / sqrtf(ss * (1.f / 256.f) + EPS); const f32x4 w = *(const f32x4*)(kv_a_norm + 4 * lane); const f32x4 o = v * rstd * w;
        *(f32x4*)(dst + 4 * lane) = o;
        v2u pk; pk.x = pk2(o.x, o.y); pk.y = pk2(o.z, o.w); *(v2u*)(KB + (size_t)row * QK + 4 * lane) = pk; }
    if (lane < 32) {
        const float x1 = KRR[(size_t)row * 64 + lane], x2 = KRR[(size_t)row * 64 + 32 + lane], c = tab[pidx * 64 + lane], s = tab[pidx * 64 + 32 + lane];
        const float a = x1 * c - x2 * s, b = x1 * s + x2 * c; float* dst = row < NTOK ? kr_p + (size_t)row * 64 : kr_s + (size_t)(row - NTOK) * 64; dst[lane] = a; dst[32 + lane] = b;
        KB[(size_t)row * QK + 256 + lane] = (bf16)f2bf(a); KB[(size_t)row * QK + 288 + lane] = (bf16)f2bf(b); }
    if (lane < 16) DTV[(size_t)row * 16 + lane] = softplusf(DTR[(size_t)row * 16 + lane] + dt_bias[lane]);
#pragma unroll 1
    for (int i = 0; i < 3; ++i) {
        const int c0 = 8 * lane + 512 * i; float xp[4][8];
        if (row < NTOK) { const int s = row % SEQ;
#pragma unroll
            for (int k = 0; k < 4; ++k) { const bool ok = s + k - 3 >= 0; const v4u w = ok ? *(const v4u*)(XBR + (size_t)(row + k - 3) * CONVD + c0) : (v4u){0u, 0u, 0u, 0u};
                xp[k][0] = bf2f((unsigned short)(w.x & 0xffffu)); xp[k][1] = bf2f((unsigned short)(w.x >> 16)); xp[k][2] = bf2f((unsigned short)(w.y & 0xffffu)); xp[k][3] = bf2f((unsigned short)(w.y >> 16));
                xp[k][4] = bf2f((unsigned short)(w.z & 0xffffu)); xp[k][5] = bf2f((unsigned short)(w.z >> 16)); xp[k][6] = bf2f((unsigned short)(w.w & 0xffffu)); xp[k][7] = bf2f((unsigned short)(w.w >> 16)); } }
        else { const int b = row - NTOK;
#pragma unroll
            for (int k = 0; k < 3; ++k) { const float* src = state_conv + ((size_t)b * 3 + k) * CONVD + c0;
#pragma unroll
                for (int e = 0; e < 8; ++e) xp[k][e] = src[e]; }
            { const v4u w = *(const v4u*)(XBR + (size_t)row * CONVD + c0);
                xp[3][0] = bf2f((unsigned short)(w.x & 0xffffu)); xp[3][1] = bf2f((unsigned short)(w.x >> 16)); xp[3][2] = bf2f((unsigned short)(w.y & 0xffffu)); xp[3][3] = bf2f((unsigned short)(w.y >> 16));
                xp[3][4] = bf2f((unsigned short)(w.z & 0xffffu)); xp[3][5] = bf2f((unsigned short)(w.z >> 16)); xp[3][6] = bf2f((unsigned short)(w.w & 0xffffu)); xp[3][7] = bf2f((unsigned short)(w.w >> 16)); }
#pragma unroll
            for (int k = 0; k < 2; ++k) { float* d = conv_s + ((size_t)b * 3 + k) * CONVD + c0;
#pragma unroll
                for (int e = 0; e < 8; ++e) d[e] = xp[k + 1][e]; } }
        float o[8];
#pragma unroll
        for (int e = 0; e < 8; ++e) { float a = conv_b[c0 + e];
#pragma unroll
            for (int k = 0; k < 4; ++k) a += xp[k][e] * conv_w[k * CONVD + c0 + e];
            o[e] = siluf(a); }
        v4u pk; pk.x = pk2(o[0], o[1]); pk.y = pk2(o[2], o[3]); pk.z = pk2(o[4], o[5]); pk.w = pk2(o[6], o[7]);
        *(v4u*)(XACT + (size_t)row * CONVD + c0) = pk; }
}
__device__ __forceinline__ void unpack8(const v4u w, float (&x)[8]) {
    x[0] = bf2f((unsigned short)(w.x & 0xffffu)); x[1] = bf2f((unsigned short)(w.x >> 16)); x[2] = bf2f((unsigned short)(w.y & 0xffffu)); x[3] = bf2f((unsigned short)(w.y >> 16));
    x[4] = bf2f((unsigned short)(w.z & 0xffffu)); x[5] = bf2f((unsigned short)(w.z >> 16)); x[6] = bf2f((unsigned short)(w.w & 0xffffu)); x[7] = bf2f((unsigned short)(w.w >> 16)); }
__device__ __forceinline__ void p2_run(int rr, int lane, const float* KRR, const float* DTR, const bf16* XBR, const float* kv_a_norm, const float* tab, const float* dt_bias, const float* conv_w, const float* conv_b,
                                       bf16* KB, float* DTV, bf16* XACT, float* ckv_p, float* kr_p) {
    const int row0 = 8 * rr, s0 = row0 % SEQ;
    const f32x4 wn = *(const f32x4*)(kv_a_norm + 4 * lane);
#pragma unroll 1
    for (int i = 0; i < 3; ++i) {
        const int c0 = 8 * lane + 512 * i; float cw[4][8], cb[8];
#pragma unroll
        for (int k = 0; k < 4; ++k) { const f32x4 a = *(const f32x4*)(conv_w + k * CONVD + c0), b2 = *(const f32x4*)(conv_w + k * CONVD + c0 + 4);
            cw[k][0] = a.x; cw[k][1] = a.y; cw[k][2] = a.z; cw[k][3] = a.w; cw[k][4] = b2.x; cw[k][5] = b2.y; cw[k][6] = b2.z; cw[k][7] = b2.w; }
        { const f32x4 a = *(const f32x4*)(conv_b + c0), b2 = *(const f32x4*)(conv_b + c0 + 4); cb[0] = a.x; cb[1] = a.y; cb[2] = a.z; cb[3] = a.w; cb[4] = b2.x; cb[5] = b2.y; cb[6] = b2.z; cb[7] = b2.w; }
        float x0[8], x1[8], x2[8];
        { const bool ok = s0 > 0; const bf16* src = XBR + (size_t)(row0 - 3) * CONVD + c0;
          const v4u z4 = (v4u){0u, 0u, 0u, 0u}; unpack8(ok ? *(const v4u*)src : z4, x0); unpack8(ok ? *(const v4u*)(src + CONVD) : z4, x1); unpack8(ok ? *(const v4u*)(src + 2 * CONVD) : z4, x2); }
        v4u cur[8];
#pragma unroll
        for (int r = 0; r < 8; ++r) cur[r] = *(const v4u*)(XBR + (size_t)(row0 + r) * CONVD + c0);
#pragma unroll
        for (int r = 0; r < 8; ++r) { float x3[8], o[8]; unpack8(cur[r], x3);
#pragma unroll
            for (int e = 0; e < 8; ++e) { const float a = cb[e] + x0[e] * cw[0][e] + x1[e] * cw[1][e] + x2[e] * cw[2][e] + x3[e] * cw[3][e]; o[e] = a / (1.0f + __expf(-a)); x0[e] = x1[e]; x1[e] = x2[e]; x2[e] = x3[e]; }
            v4u pk; pk.x = pk2(o[0], o[1]); pk.y = pk2(o[2], o[3]); pk.z = pk2(o[4], o[5]); pk.w = pk2(o[6], o[7]);
            *(v4u*)(XACT + (size_t)(row0 + r) * CONVD + c0) = pk; } }
#pragma unroll 2
    for (int r = 0; r < 8; ++r) { const int row = row0 + r, pidx = s0 + r;
        {   float* dst = ckv_p + (size_t)row * 256;
            const f32x4 v = *(const f32x4*)(dst + 4 * lane); const float ss = wave_sum((v.x * v.x + v.y * v.y) + (v.z * v.z + v.w * v.w));
            const float rstd = 1.0f / sqrtf(ss * (1.f / 256.f) + EPS); const f32x4 o = v * rstd * wn;
            *(f32x4*)(dst + 4 * lane) = o;
            v2u pk; pk.x = pk2(o.x, o.y); pk.y = pk2(o.z, o.w); *(v2u*)(KB + (size_t)row * QK + 4 * lane) = pk; }
        if (lane < 32) {
            const float x1 = KRR[(size_t)row * 64 + lane], x2 = KRR[(size_t)row * 64 + 32 + lane], c = tab[pidx * 64 + lane], s = tab[pidx * 64 + 32 + lane];
            const float a = x1 * c - x2 * s, b = x1 * s + x2 * c; float* dst = kr_p + (size_t)row * 64; dst[lane] = a; dst[32 + lane] = b;
            KB[(size_t)row * QK + 256 + lane] = (bf16)f2bf(a); KB[(size_t)row * QK + 288 + lane] = (bf16)f2bf(b); }
        if (lane < 16) DTV[(size_t)row * 16 + lane] = softplusf(DTR[(size_t)row * 16 + lane] + dt_bias[lane]); }
}
}
namespace at {
using namespace mk;
typedef float f32x16 __attribute__((ext_vector_type(16)));
typedef short s16x4 __attribute__((ext_vector_type(4)));
constexpr int KVBUF = 40960, PX_OFF = 3 * KVBUF, PX_PAIR = 32 * 144, MX_OFF = PX_OFF + 4 * PX_PAIR, LB_OFF = MX_OFF + 1024, AT_LDS_END = LB_OFF + 1024;
constexpr size_t WS_WUVF = 292 * MiB;
__device__ __forceinline__ void wuvf_item(const float* w_uv, bf16* WUVF, int item, int lane) {
    const int vt = item & 3, s2 = (item >> 2) & 1, c = (item >> 3) & 3, kh = (item >> 5) & 1, head = item >> 6, vv = lane & 31, h2 = lane >> 5;
    unsigned w[4];
#pragma unroll
    for (int jj = 0; jj < 4; ++jj) { float e[2];
#pragma unroll
        for (int q = 0; q < 2; ++q) { const int j = 2 * jj + q, r = 128 * kh + 32 * c + 16 * s2 + 8 * (j >> 2) + 4 * h2 + (j & 3); e[q] = w_uv[((size_t)r * 8 + head) * 128 + 32 * vt + vv]; }
        w[jj] = pk2(e[0], e[1]); }
    *(v4u*)(WUVF + ((size_t)item * 64 + lane) * 8) = (v4u){w[0], w[1], w[2], w[3]};
}
__device__ __forceinline__ void glds16(const void* gsrc, unsigned lds_dst) { unsigned keep;
    asm volatile("s_mov_b32 %0, m0\n\ts_mov_b32 m0, %2\n\ts_nop 0\n\tglobal_load_lds_dwordx4 %1, off\n\ts_mov_b32 m0, %0" : "=&s"(keep) : "v"(gsrc), "s"(lds_dst) : "memory"); }
typedef float f32x2_t __attribute__((ext_vector_type(2))); typedef __bf16 bf16x2_t __attribute__((ext_vector_type(2)));
__device__ __forceinline__ unsigned cvtpk(float lo, float hi) { f32x2_t v = {lo, hi}; bf16x2_t b = __builtin_convertvector(v, bf16x2_t); return __builtin_bit_cast(unsigned, b); }
__device__ __forceinline__ s16x4 vtr(unsigned addr) { typedef short v4i16_t __attribute__((ext_vector_type(4))); return __builtin_bit_cast(s16x4, __builtin_amdgcn_ds_read_tr16_b64_v4i16((LAS v4i16_t*)(size_t)addr)); }
#define AT_BAR(N) asm volatile("s_waitcnt vmcnt(" #N ") lgkmcnt(0)\n\ts_barrier" ::: "memory")
#define AT_BARL() asm volatile("s_waitcnt lgkmcnt(0)\n\ts_barrier" ::: "memory")

__device__ __forceinline__ void attn_unit(LAS unsigned char* L, const bf16* __restrict__ QB, const bf16* __restrict__ KB, int b, int hg, int j, const bf16* __restrict__ WUVF, const bf16* __restrict__ ZA, bf16* __restrict__ MIX, int wave, int lane) {
    const int pair = wave >> 1, kh = wave & 1, h = hg * 4 + pair;
    const int q0 = 32 * j, NT = (j >> 1) + 1, rowbase = b * SEQ;
    const int ql = lane & 31, hh = lane >> 5;
    const unsigned lds0 = (unsigned)(size_t)L;
    bf16x8 qf[20];
    const bf16* kbase = KB + (size_t)rowbase * QK;
    unsigned soff0, soff4;
    { const int row4 = 4 * wave + (lane >> 4), ch = (lane & 15) ^ (((row4 & 3) << 2) | ((row4 >> 2) & 3));
      soff0 = (unsigned)(row4 * QK + 8 * ch);
      const int rb = wave >> 2, g = wave & 3, row8 = 8 * g + (lane >> 3), ch8 = (lane & 7) ^ ((row8 >> 1) & 7);
      soff4 = (unsigned)((32 * rb + row8) * QK + 256 + 8 * ch8); }
#define AT_DMA(t, bufi) do { const bf16* _s = kbase + (size_t)(t) * 64 * QK; const unsigned _d = lds0 + (bufi) * KVBUF + wave * 1024; \
        _Pragma("unroll") for (int _i = 0; _i < 4; ++_i) glds16(_s + soff0 + (32 * (_i >> 1) * QK + 128 * (_i & 1)), (unsigned)__builtin_amdgcn_readfirstlane(_d + _i * 8192)); \
        glds16(_s + soff4, (unsigned)__builtin_amdgcn_readfirstlane(_d + 32768)); } while (0)
    const unsigned wq = (unsigned)(hh ^ (((ql & 3) << 2) | ((ql >> 2) & 3)));
    const unsigned wr = (unsigned)(hh ^ ((ql >> 1) & 7));
    const unsigned ka = lds0 + (kh * 2) * 8192 + 256 * ql, kr = lds0 + 32768 + kh * 4096 + 128 * ql;
    unsigned vbase[2];
    { const int blk = (lane >> 4) & 1, qq = (lane & 15) >> 2, p = lane & 3, x = 2 * blk + (p >> 1);
#pragma unroll
      for (int t = 0; t < 2; ++t) { const int y = (2 * hh + t) & 3; vbase[t] = lds0 + (unsigned)(2048 * hh + 1024 * t + 256 * qq + 64 * qq + 16 * (x ^ y) + 8 * (p & 1)); } }
    const unsigned pxw = lds0 + PX_OFF + pair * PX_PAIR + ql * 144 + (32 * kh + 4 * hh) * 2;
    const unsigned pxr = lds0 + PX_OFF + pair * PX_PAIR + ql * 144 + 16 * hh;
    LAS float* MX = (LAS float*)(L + MX_OFF) + pair * 64; LAS float* LB = (LAS float*)(L + LB_OFF) + pair * 64;
    f32x16 oacc[4];
#pragma unroll
    for (int c = 0; c < 4; ++c) oacc[c] = (f32x16){};
    float m_ref = 0.f, lsum = 0.f;
    AT_DMA(0, 0); if (NT > 1) AT_DMA(1, 1);
    { const bf16* qp = QB + (size_t)(rowbase + q0 + ql) * 2560 + h * 320 + 8 * hh;
#pragma unroll
      for (int ks = 0; ks < 20; ++ks) qf[ks] = *(const bf16x8*)(qp + 16 * ks);
#pragma unroll
      for (int ks = 0; ks < 20; ++ks) asm volatile("" : "+v"(qf[ks])); }
    int buf = 0;
    for (int t = 0; t < NT; ++t) {
        if (t + 1 < NT) AT_BAR(5); else AT_BAR(0);
        if (t + 2 < NT) { const int nb = buf == 0 ? 2 : buf - 1; AT_DMA(t + 2, nb); }
        const unsigned kvb = (unsigned)buf * KVBUF;
        f32x16 sacc = (f32x16){};
        {
#define AT_KLD(dst, g2) do { _Pragma("unroll") for (int i = 0; i < 2; ++i) { const int ks = 2 * (g2) + i; \
                if (ks < 16) dst[i] = *(const LAS bf16x8*)(size_t)(ka + kvb + (ks >> 3) * 8192 + 16 * ((unsigned)(2 * (ks & 7)) ^ wq)); \
                else dst[i] = *(const LAS bf16x8*)(size_t)(kr + kvb + 16 * ((unsigned)(2 * (ks - 16)) ^ wr)); } } while (0)
#define AT_KMM(src, g2) do { _Pragma("unroll") for (int i = 0; i < 2; ++i) sacc = __builtin_amdgcn_mfma_f32_32x32x16_bf16(src[i], qf[2 * (g2) + i], sacc, 0, 0, 0); } while (0)
#define AT_SB() __builtin_amdgcn_sched_barrier(0)
            bf16x8 k0[2], k1[2], k2[2];
            AT_KLD(k0, 0); AT_KLD(k1, 1); AT_SB();
            AT_KLD(k2, 2); AT_SB(); AT_KMM(k0, 0); AT_SB();
            AT_KLD(k0, 3); AT_SB(); AT_KMM(k1, 1); AT_SB();
            AT_KLD(k1, 4); AT_SB(); AT_KMM(k2, 2); AT_SB();
            AT_KLD(k2, 5); AT_SB(); AT_KMM(k0, 3); AT_SB();
            AT_KLD(k0, 6); AT_SB(); AT_KMM(k1, 4); AT_SB();
            AT_KLD(k1, 7); AT_SB(); AT_KMM(k2, 5); AT_SB();
            AT_KLD(k2, 8); AT_SB(); AT_KMM(k0, 6); AT_SB();
            AT_KLD(k0, 9); AT_SB(); AT_KMM(k1, 7); AT_SB();
            AT_KMM(k2, 8); AT_SB(); AT_KMM(k0, 9); AT_SB();
        }
        if (t == NT - 1) {
            const int qg = q0 + ql, kb0 = 64 * t + 32 * kh + 4 * hh;
#pragma unroll
            for (int r = 0; r < 16; ++r) { const int kg = kb0 + (r & 3) + 8 * (r >> 2); if (kg > qg) sacc[r] = -INFINITY; }
        }
        float mx = sacc[0];
#pragma unroll
        for (int r = 1; r < 16; ++r) mx = fmaxf(mx, sacc[r]);
        mx = fmaxf(mx, __shfl_xor(mx, 32));
#pragma unroll
        for (int r = 0; r < 16; ++r) { sacc[r] = __builtin_amdgcn_exp2f(sacc[r] - m_ref); lsum += sacc[r]; }
#pragma unroll
        for (int g = 0; g < 4; ++g) { v2u w; w.x = cvtpk(sacc[4 * g], sacc[4 * g + 1]); w.y = cvtpk(sacc[4 * g + 2], sacc[4 * g + 3]); *(LAS v2u*)(size_t)(pxw + 16 * g) = w; }
        if (hh == 0) MX[kh * 32 + ql] = mx;
        AT_BARL();
        const float mxp = MX[(kh ^ 1) * 32 + ql];
        bf16x8 pf[4];
#pragma unroll
        for (int i = 0; i < 4; ++i) pf[i] = *(const LAS bf16x8*)(size_t)(pxr + 64 * (i >> 1) + 32 * (i & 1));
        {
#define AT_VLD(lo, hi, n) do { const int i_ = (n) >> 2, c_ = (n) & 3; const unsigned vb_ = kvb + (unsigned)(((i_ >> 1) * 2 + kh) * 8192 + 4096 * (i_ & 1)); \
                lo = vtr((vbase[0] + vb_) ^ (unsigned)(c_ << 6)); hi = vtr((vbase[1] + vb_) ^ (unsigned)(c_ << 6)); } while (0)
#define AT_VMM(lo, hi, n) do { const bf16x8 vf_ = (bf16x8){lo[0], lo[1], lo[2], lo[3], hi[0], hi[1], hi[2], hi[3]}; oacc[(n) & 3] = __builtin_amdgcn_mfma_f32_32x32x16_bf16(vf_, pf[(n) >> 2], oacc[(n) & 3], 0, 0, 0); } while (0)
            s16x4 la, ha, lb, hb;
            AT_VLD(la, ha, 0); AT_SB();
#pragma unroll
            for (int n = 0; n < 16; n += 2) {
                AT_VLD(lb, hb, n + 1); AT_SB(); AT_VMM(la, ha, n); AT_SB();
                if (n + 2 < 16) { AT_VLD(la, ha, n + 2); AT_SB(); }
                AT_VMM(lb, hb, n + 1); AT_SB(); }
        }
        const float m_new = fmaxf(m_ref, fmaxf(mx, mxp));
        if (__any(m_new != m_ref)) { const float al = __builtin_amdgcn_exp2f(m_ref - m_new); lsum *= al;
#pragma unroll
            for (int c = 0; c < 4; ++c) oacc[c] *= al;
            m_ref = m_new; }
        buf = buf == 2 ? 0 : buf + 1;
    }
    lsum += __shfl_xor(lsum, 32);
    if (hh == 0) LB[kh * 32 + ql] = lsum;
    AT_BARL();
    { int l_; asm volatile("v_mbcnt_lo_u32_b32 %0, -1, 0\n\tv_mbcnt_hi_u32_b32 %0, -1, %0" : "=v"(l_)); lane = l_; }
    const int qe = lane & 31, he = lane >> 5;
    const float inv = 1.0f / (LB[qe] + LB[32 + qe]);
    f32x16 uacc[4];
#pragma unroll
    for (int vt = 0; vt < 4; ++vt) uacc[vt] = (f32x16){};
    { const bf16* wf = WUVF + ((size_t)((h * 2 + kh) * 32) * 64 + lane) * 8;
#pragma unroll
      for (int c = 0; c < 4; ++c)
#pragma unroll
        for (int s2 = 0; s2 < 2; ++s2) {
            v4u ow; ow.x = cvtpk(oacc[c][8 * s2], oacc[c][8 * s2 + 1]); ow.y = cvtpk(oacc[c][8 * s2 + 2], oacc[c][8 * s2 + 3]); ow.z = cvtpk(oacc[c][8 * s2 + 4], oacc[c][8 * s2 + 5]); ow.w = cvtpk(oacc[c][8 * s2 + 6], oacc[c][8 * s2 + 7]);
#pragma unroll
            for (int vt = 0; vt < 4; ++vt) { const bf16x8 af = *(const bf16x8*)(wf + (size_t)(((c * 2 + s2) * 4 + vt) * 64) * 8);
                uacc[vt] = __builtin_amdgcn_mfma_f32_32x32x16_bf16(af, __builtin_bit_cast(bf16x8, ow), uacc[vt], 0, 0, 0); } } }
    { LAS float* xs = (LAS float*)(L) + (pair * 2 + kh) * 2048 + lane; LAS float* xr = (LAS float*)(L) + (pair * 2 + (kh ^ 1)) * 2048 + lane;
      f32x16 keep0, keep1;
      if (kh == 0) { keep0 = uacc[0]; keep1 = uacc[1];
#pragma unroll
          for (int r = 0; r < 16; ++r) { xs[r * 64] = uacc[2][r]; xs[(16 + r) * 64] = uacc[3][r]; } }
      else { keep0 = uacc[2]; keep1 = uacc[3];
#pragma unroll
          for (int r = 0; r < 16; ++r) { xs[r * 64] = uacc[0][r]; xs[(16 + r) * 64] = uacc[1][r]; } }
      AT_BARL();
      const bf16* zr = ZA + (size_t)(rowbase + q0 + qe) * 1024 + h * 128 + 64 * kh + 4 * he;
      bf16* mr = MIX + (size_t)(rowbase + q0 + qe) * DMIX + h * 128 + 64 * kh + 4 * he;
#pragma unroll
      for (int ti = 0; ti < 2; ++ti)
#pragma unroll
        for (int g = 0; g < 4; ++g) { const v2u zw = *(const v2u*)(zr + 32 * ti + 8 * g); const float z[4] = {bf2f((unsigned short)(zw.x & 0xffffu)), bf2f((unsigned short)(zw.x >> 16)), bf2f((unsigned short)(zw.y & 0xffffu)), bf2f((unsigned short)(zw.y >> 16))}; float o[4];
#pragma unroll
            for (int e = 0; e < 4; ++e) { const int r = 4 * g + e; o[e] = ((ti == 0 ? keep0[r] : keep1[r]) + xr[(ti * 16 + r) * 64]) * inv * z[e]; }
            v2u w; w.x = cvtpk(o[0], o[1]); w.y = cvtpk(o[2], o[3]); *(v2u*)(mr + 32 * ti + 8 * g) = w; }
      AT_BARL(); }
#undef AT_DMA
}
__device__ __forceinline__ void attn_phase(LAS unsigned char* L, const bf16* QB, const bf16* KB, const bf16* WUVF, const bf16* ZA, bf16* MIX, int wave, int lane) {
    const bool bal = gridDim.x == 256; const int c = blockIdx.x, lo = c < 128, i8 = c & 7;
    const int n = bal ? (lo ? 3 : 5) : 2 * ((511 - c) / (int)gridDim.x + 1);
#pragma unroll 1
    for (int k = 0; k < n; ++k) {
        int bh, j;
        if (bal) { bh = (c & 127) >> 3;
            if (lo) j = k == 0 ? 47 - i8 : k == 1 ? 16 + i8 : 24 + i8;
            else j = k == 0 ? 63 - i8 : k == 1 ? i8 : k == 2 ? 55 - i8 : k == 3 ? 8 + i8 : 39 - i8; }
        else { const int pi = c + (k >> 1) * (int)gridDim.x, jp = pi & 31; bh = pi >> 5; j = (k & 1) ? jp : 63 - jp; }
        attn_unit(L, QB, KB, bh >> 1, bh & 1, j, WUVF, ZA, MIX, wave, lane);
    }
    asm volatile("s_waitcnt vmcnt(0) lgkmcnt(0)" ::: "memory");
}
}
namespace dc {
using namespace at;
constexpr int QS_OFF = 2 * KVBUF, QS_ROW = 656, DPX_OFF = QS_OFF + 32 * QS_ROW, DMX_OFF = DPX_OFF + PX_PAIR, DLB_OFF = DMX_OFF + 256, DFLAG_OFF = DLB_OFF + 256;
constexpr size_t WS_PART = 300 * MiB;
constexpr size_t CTL_DCNT = 65536 + 2 * 131072;
constexpr int PREC = 260;
constexpr size_t CTL_DROWS = 65536 + 2 * 131072 + 1024;
typedef float f32x4n __attribute__((ext_vector_type(4)));
__device__ __forceinline__ f32x4 ldnt(const float* p) { return __builtin_nontemporal_load((const f32x4*)p); }

__device__ __forceinline__ void dec_unit(LAS unsigned char* L, const bf16* __restrict__ QB, const bf16* __restrict__ KB, const float* __restrict__ cache_ckv, const float* __restrict__ cache_kr,
                                         const int* __restrict__ page_table, int b, int split, float* PART, unsigned* DCNT, unsigned* DROWS, const float* __restrict__ w_uv, const bf16* __restrict__ ZA, bf16* __restrict__ MIX, int wave, int lane) {
    const int row = NTOK + b, ql = lane & 31, hh = lane >> 5;
    const unsigned lds0 = (unsigned)(size_t)L;
    { const int tid = wave * 64 + lane;
      for (int i = tid; i < 32 * 40; i += 512) { const int r = i / 40, c = i % 40; v4u v = (v4u){0u, 0u, 0u, 0u}; if (r < 8) v = *(const v4u*)(QB + (size_t)row * 2560 + r * 320 + 8 * c);
          *(LAS v4u*)(size_t)(lds0 + QS_OFF + r * QS_ROW + 16 * c) = v; } }
    const int ptv = page_table[b * NPAGES + split * 32 + (lane & 31)];
    constexpr int NT = 64;
    f32x4 sa[10], sb[10];
#define DC_LOAD(dst, t) do { const size_t _pg = (size_t)(unsigned)__builtin_amdgcn_readlane(ptv, (t) >> 1); const size_t _k0 = _pg * PAGE + 64 * ((t) & 1) + 8 * wave; \
        _Pragma("unroll") for (int _i = 0; _i < 8; ++_i) dst[_i] = ldnt(cache_ckv + (_k0 + _i) * KVR + 4 * lane); \
        _Pragma("unroll") for (int _i = 0; _i < 2; ++_i) dst[8 + _i] = ldnt(cache_kr + _k0 * ROPE + 256 * _i + 4 * lane); } while (0)
    const int rbw = wave >> 2;
    unsigned wck;
    { const int ch = lane >> 1; wck = (unsigned)((rbw * 2 + (ch >> 4)) * 8192 + 8 * (lane & 1)); }
#define DC_WRITE(src, bufb) do { \
        _Pragma("unroll") for (int _i = 0; _i < 8; ++_i) { const int _r = (8 * wave + _i) & 31; const unsigned _a = lds0 + (bufb) + wck + 256 * _r + 16 * ((unsigned)((lane >> 1) & 15) ^ (unsigned)(((_r & 3) << 2) | ((_r >> 2) & 3))); \
            v2u _w; _w.x = cvtpk(src[_i].x, src[_i].y); _w.y = cvtpk(src[_i].z, src[_i].w); *(LAS v2u*)(size_t)_a = _w; } \
        _Pragma("unroll") for (int _i = 0; _i < 2; ++_i) { const int _r = (8 * wave + 4 * _i + (lane >> 4)) & 31; const unsigned _a = lds0 + (bufb) + 32768 + rbw * 4096 + 128 * _r + 16 * ((unsigned)((lane & 15) >> 1) ^ (unsigned)((_r >> 1) & 7)) + 8 * (lane & 1); \
            v2u _w; _w.x = cvtpk(src[8 + _i].x, src[8 + _i].y); _w.y = cvtpk(src[8 + _i].z, src[8 + _i].w); *(LAS v2u*)(size_t)_a = _w; } } while (0)
    const int kh = wave & 1;
    const unsigned wq = (unsigned)(hh ^ (((ql & 3) << 2) | ((ql >> 2) & 3))), wr = (unsigned)(hh ^ ((ql >> 1) & 7));
    const unsigned ka = lds0 + (kh * 2) * 8192 + 256 * ql, kr = lds0 + 32768 + kh * 4096 + 128 * ql;
    unsigned vbase[2];
    { const int blk = (lane >> 4) & 1, qq = (lane & 15) >> 2, p = lane & 3, x = 2 * blk + (p >> 1);
#pragma unroll
      for (int t = 0; t < 2; ++t) { const int y = (2 * hh + t) & 3; vbase[t] = lds0 + (unsigned)(2048 * hh + 1024 * t + 256 * qq + 64 * qq + 16 * (x ^ y) + 8 * (p & 1)); } }
    const unsigned qsr = lds0 + QS_OFF + ql * QS_ROW + 16 * hh;
    const unsigned pxw = lds0 + DPX_OFF + ql * 144 + (32 * kh + 4 * hh) * 2, pxr = lds0 + DPX_OFF + ql * 144 + 16 * hh;
    LAS float* MX = (LAS float*)(L + DMX_OFF); LAS float* LB = (LAS float*)(L + DLB_OFF);
    f32x16 oacc = (f32x16){};
    float m_ref = 0.f, lsum = 0.f;
    DC_LOAD(sa, 0); DC_LOAD(sb, 1);
#define DC_SB() __builtin_amdgcn_sched_barrier(0)
#define DC_KLD(kd, qd, g2) do { _Pragma("unroll") for (int i = 0; i < 2; ++i) { const int ks = 2 * (g2) + i; qd[i] = *(const LAS bf16x8*)(size_t)(qsr + 32 * ks); \
        if (ks < 16) kd[i] = *(const LAS bf16x8*)(size_t)(ka + kvb + (ks >> 3) * 8192 + 16 * ((unsigned)(2 * (ks & 7)) ^ wq)); \
        else kd[i] = *(const LAS bf16x8*)(size_t)(kr + kvb + 16 * ((unsigned)(2 * (ks - 16)) ^ wr)); } } while (0)
#define DC_KMM(kd, qd) do { _Pragma("unroll") for (int i = 0; i < 2; ++i) sacc = __builtin_amdgcn_mfma_f32_32x32x16_bf16(kd[i], qd[i], sacc, 0, 0, 0); } while (0)
#define DC_TILE(src, t) do { const unsigned kvb = (unsigned)(((t) & 1) * KVBUF); \
        DC_WRITE(src, kvb); \
        DC_LOAD(src, ((t) + 2 < NT ? (t) + 2 : NT - 1));   \
        AT_BARL(); \
        float mx = 0.f; \
        if (wave < 2) { f32x16 sacc = (f32x16){}; \
            bf16x8 k0[2], k1[2], k2[2], q0[2], q1[2], q2[2]; \
            DC_KLD(k0, q0, 0); DC_KLD(k1, q1, 1); DC_SB(); \
            DC_KLD(k2, q2, 2); DC_SB(); DC_KMM(k0, q0); DC_SB(); \
            DC_KLD(k0, q0, 3); DC_SB(); DC_KMM(k1, q1); DC_SB(); \
            DC_KLD(k1, q1, 4); DC_SB(); DC_KMM(k2, q2); DC_SB(); \
            DC_KLD(k2, q2, 5); DC_SB(); DC_KMM(k0, q0); DC_SB(); \
            DC_KLD(k0, q0, 6); DC_SB(); DC_KMM(k1, q1); DC_SB(); \
            DC_KLD(k1, q1, 7); DC_SB(); DC_KMM(k2, q2); DC_SB(); \
            DC_KLD(k2, q2, 8); DC_SB(); DC_KMM(k0, q0); DC_SB(); \
            DC_KLD(k0, q0, 9); DC_SB(); DC_KMM(k1, q1); DC_SB(); \
            DC_KMM(k2, q2); DC_SB(); DC_KMM(k0, q0); DC_SB(); \
            mx = sacc[0]; \
            _Pragma("unroll") for (int r = 1; r < 16; ++r) mx = fmaxf(mx, sacc[r]); \
            mx = fmaxf(mx, __shfl_xor(mx, 32)); \
            _Pragma("unroll") for (int r = 0; r < 16; ++r) { sacc[r] = __builtin_amdgcn_exp2f(sacc[r] - m_ref); lsum += sacc[r]; } \
            _Pragma("unroll") for (int g = 0; g < 4; ++g) { v2u w; w.x = cvtpk(sacc[4 * g], sacc[4 * g + 1]); w.y = cvtpk(sacc[4 * g + 2], sacc[4 * g + 3]); *(LAS v2u*)(size_t)(pxw + 16 * g) = w; } \
            if (hh == 0) MX[kh * 32 + ql] = mx; } \
        AT_BARL(); \
        { const float m_new = fmaxf(m_ref, fmaxf(MX[ql], MX[32 + ql])); \
          bf16x8 pf[4]; \
          _Pragma("unroll") for (int i = 0; i < 4; ++i) pf[i] = *(const LAS bf16x8*)(size_t)(pxr + 64 * (i >> 1) + 32 * (i & 1)); \
          _Pragma("unroll") for (int i = 0; i < 4; ++i) { const unsigned vb = kvb + (unsigned)(((i >> 1) * 2 + (wave >> 2)) * 8192 + 4096 * (i & 1)); \
              const s16x4 lo = vtr((vbase[0] + vb) ^ (unsigned)((wave & 3) << 6)), hi = vtr((vbase[1] + vb) ^ (unsigned)((wave & 3) << 6)); \
              const bf16x8 vf = (bf16x8){lo[0], lo[1], lo[2], lo[3], hi[0], hi[1], hi[2], hi[3]}; \
              oacc = __builtin_amdgcn_mfma_f32_32x32x16_bf16(vf, pf[i], oacc, 0, 0, 0); } \
          if (__any(m_new != m_ref)) { const float al = __builtin_amdgcn_exp2f(m_ref - m_new); lsum *= al; oacc *= al; m_ref = m_new; } } \
    } while (0)
#pragma unroll 1
    for (int t = 0; t < NT; t += 2) { DC_TILE(sa, t); DC_TILE(sb, t + 1); }
    lsum += __shfl_xor(lsum, 32);
    if (wave < 2 && hh == 0) LB[kh * 32 + ql] = lsum;
    AT_BARL();
    float* pr = PART + ((size_t)(b * 2 + split) * 8) * PREC;
    if (ql < 8) { float* ph = pr + ql * PREC;
        typedef unsigned long long u64;
        if (wave == 0 && hh == 0) __hip_atomic_store((u64*)ph, ((u64)__float_as_uint(LB[ql] + LB[32 + ql]) << 32) | (u64)__float_as_uint(m_ref), __ATOMIC_RELAXED, __HIP_MEMORY_SCOPE_AGENT);
#pragma unroll
        for (int g = 0; g < 4; ++g) { u64* d = (u64*)(ph + 4 + 32 * wave + 8 * g + 4 * hh);
            __hip_atomic_store(d, ((u64)__float_as_uint(oacc[4 * g + 1]) << 32) | (u64)__float_as_uint(oacc[4 * g]), __ATOMIC_RELAXED, __HIP_MEMORY_SCOPE_AGENT);
            __hip_atomic_store(d + 1, ((u64)__float_as_uint(oacc[4 * g + 3]) << 32) | (u64)__float_as_uint(oacc[4 * g + 2]), __ATOMIC_RELAXED, __HIP_MEMORY_SCOPE_AGENT); } }
    asm volatile("s_waitcnt vmcnt(0) lgkmcnt(0)\n\ts_barrier" ::: "memory");
    LAS unsigned* flag = (LAS unsigned*)(L + DFLAG_OFF);
    if (wave == 0 && lane == 0) { const unsigned old = __hip_atomic_fetch_add(DCNT + b, 1u, __ATOMIC_RELAXED, __HIP_MEMORY_SCOPE_AGENT); *flag = old; }
    AT_BARL();
    const unsigned old = *flag;
    if (old == 1u) {
        __builtin_amdgcn_fence(__ATOMIC_ACQUIRE, "agent");
        const int h = wave;
        const float* p0 = PART + ((size_t)(b * 2 + 0) * 8 + h) * PREC; const float* p1 = PART + ((size_t)(b * 2 + 1) * 8 + h) * PREC;
        const float m0 = __hip_atomic_load(p0, __ATOMIC_RELAXED, __HIP_MEMORY_SCOPE_AGENT), l0 = __hip_atomic_load(p0 + 1, __ATOMIC_RELAXED, __HIP_MEMORY_SCOPE_AGENT);
        const float m1 = __hip_atomic_load(p1, __ATOMIC_RELAXED, __HIP_MEMORY_SCOPE_AGENT), l1 = __hip_atomic_load(p1 + 1, __ATOMIC_RELAXED, __HIP_MEMORY_SCOPE_AGENT);
        const f32x4 o0 = *(const f32x4*)(p0 + 4 + 4 * lane), o1 = *(const f32x4*)(p1 + 4 + 4 * lane);
        const bf16* qrow = QB + (size_t)row * 2560 + h * 320; const bf16* krow = KB + (size_t)row * QK;
        float sn = 0.f;
#pragma unroll
        for (int i = 0; i < 5; ++i) sn += bf2f(qrow[lane + 64 * i]) * bf2f(krow[lane + 64 * i]);
        sn = wave_sum(sn);
        const float m = fmaxf(fmaxf(m0, m1), sn), w0 = __builtin_amdgcn_exp2f(m0 - m), w1 = __builtin_amdgcn_exp2f(m1 - m), wn = __builtin_amdgcn_exp2f(sn - m);
        const float inv = 1.0f / (w0 * l0 + w1 * l1 + wn);
        const v2u kc = *(const v2u*)(krow + 4 * lane);
        const f32x4 cn = (f32x4){bf2f((unsigned short)(kc.x & 0xffffu)), bf2f((unsigned short)(kc.x >> 16)), bf2f((unsigned short)(kc.y & 0xffffu)), bf2f((unsigned short)(kc.y >> 16))};
        *(LAS f32x4*)(size_t)(lds0 + 16 * (h * 64 + lane)) = (o0 * w0 + o1 * w1 + cn * wn) * inv;
        asm volatile("s_waitcnt lgkmcnt(0)" ::: "memory");
        float a0 = 0.f, a1 = 0.f;
#pragma unroll 8
        for (int r = 0; r < 256; ++r) { const float ol = *(const LAS float*)(size_t)(lds0 + 4 * (h * 256 + r)); const f32x2 wv = *(const f32x2*)(w_uv + ((size_t)r * 8 + h) * 128 + 2 * lane); a0 += ol * wv.x; a1 += ol * wv.y; }
        const unsigned zw = *(const unsigned*)(ZA + (size_t)row * 1024 + h * 128 + 2 * lane);
        *(unsigned*)(MIX + (size_t)row * DMIX + h * 128 + 2 * lane) = cvtpk(a0 * bf2f((unsigned short)(zw & 0xffffu)), a1 * bf2f((unsigned short)(zw >> 16)));
    }
    AT_BARL();
#undef DC_LOAD
#undef DC_WRITE
#undef DC_TILE
#undef DC_KLD
#undef DC_KMM
#undef DC_SB
}
__device__ __forceinline__ void dec_phase(LAS unsigned char* L, const bf16* QB, const bf16* KB, const float* cache_ckv, const float* cache_kr, const int* page_table, unsigned char* ws, const float* w_uv, const bf16* ZA, bf16* MIX, int wave, int lane) {
    for (int u = blockIdx.x; u < 256; u += gridDim.x) dec_unit(L, QB, KB, cache_ckv, cache_kr, page_table, u >> 1, u & 1, (float*)(ws + WS_PART), (unsigned*)(ws + CTL_DCNT), (unsigned*)(ws + CTL_DROWS), w_uv, ZA, MIX, wave, lane);
}
}
namespace sd {
using namespace at;
constexpr int CI_OFF = 0, BI_OFF = 32768, XT_OFF = 65536, XROW = 272, XE_OFF = XT_OFF + 64 * XROW, SB_OFF = XE_OFF + 64 * XROW, AC_OFF = SB_OFF + 64 * XROW, DT_OFF = AC_OFF + 512, SD_END = DT_OFF + 512;
constexpr float LOG2E = 1.4426950408889634f;

__device__ __forceinline__ void ssd_unit(LAS unsigned char* L, const bf16* __restrict__ XACT, const float* __restrict__ DTV, const float* __restrict__ a_log, const float* __restrict__ d_skip, const bf16* __restrict__ ZS, int b, int hd,
                                         bf16* __restrict__ MIX, float* __restrict__ SSQG, float* __restrict__ HOUT, int wave, int lane) {
    const int g = hd >> 3, ql = lane & 31, hh = lane >> 5, tid = wave * 64 + lane;
    const unsigned lds0 = (unsigned)(size_t)L;
    const int pt = wave >> 2, lt = pt == 0 ? (wave & 3) : 3 - (wave & 3), nt = wave & 3;
    const float A2 = -expf(a_log[hd]) * LOG2E;
    unsigned soffC, soffB;
    { const int row4 = 4 * wave + (lane >> 4), ch = (lane & 15) ^ (((row4 & 3) << 2) | ((row4 >> 2) & 3));
      soffC = (unsigned)(row4 * CONVD + 1280 + g * 128 + 8 * ch); soffB = (unsigned)(row4 * CONVD + 1024 + g * 128 + 8 * ch); }
    const unsigned wq = (unsigned)(hh ^ (((ql & 3) << 2) | ((ql >> 2) & 3)));
    unsigned vbase[2];
    { const int blk = (lane >> 4) & 1, qq = (lane & 15) >> 2, p = lane & 3, x = 2 * blk + (p >> 1);
#pragma unroll
      for (int t = 0; t < 2; ++t) { const int y = (2 * hh + t) & 3; vbase[t] = lds0 + BI_OFF + (unsigned)(2048 * hh + 1024 * t + 256 * qq + 64 * qq + 16 * (x ^ y) + 8 * (p & 1)); } }
    LAS float* AC = (LAS float*)(L + AC_OFF); LAS float* DT = (LAS float*)(L + DT_OFF);
    for (int i = tid; i < 64 * XROW / 16; i += 512) *(LAS v4u*)(size_t)(lds0 + SB_OFF + 16 * i) = (v4u){0u, 0u, 0u, 0u};
    f32x16 sacc = (f32x16){};
#pragma unroll 1
    for (int c = 0; c < 16; ++c) {
        const int r0 = b * SEQ + 128 * c;
        { const bf16* src = XACT + (size_t)r0 * CONVD;
#pragma unroll
          for (int lb = 0; lb < 4; ++lb) { glds16(src + (size_t)(32 * lb) * CONVD + soffC, (unsigned)__builtin_amdgcn_readfirstlane(lds0 + CI_OFF + lb * 8192 + wave * 1024));
                                           glds16(src + (size_t)(32 * lb) * CONVD + soffB, (unsigned)__builtin_amdgcn_readfirstlane(lds0 + BI_OFF + lb * 8192 + wave * 1024)); } }
        if (wave == 0) {
            const float d0 = DTV[(size_t)(r0 + lane) * 16 + hd], d1 = DTV[(size_t)(r0 + 64 + lane) * 16 + hd];
            float v0 = d0 * A2, v1 = d1 * A2;
#pragma unroll
            for (int o = 1; o < 64; o <<= 1) { const float u0 = __shfl_up(v0, o), u1 = __shfl_up(v1, o); if (lane >= o) { v0 += u0; v1 += u1; } }
            v1 += __shfl(v0, 63);
            AC[lane] = v0; AC[64 + lane] = v1; DT[lane] = d0; DT[64 + lane] = d1;
        }
        AT_BARL();
        { const int s = tid & 127, pg = tid >> 7; const float dts = DT[s], de = dts * __builtin_amdgcn_exp2f(AC[127] - AC[s]);
          const bf16* xs = XACT + (size_t)(r0 + s) * CONVD + hd * 64 + 16 * pg; const v4u xa = *(const v4u*)xs, xb = *(const v4u*)(xs + 8);
          const unsigned xw[8] = {xa.x, xa.y, xa.z, xa.w, xb.x, xb.y, xb.z, xb.w};
#pragma unroll
          for (int e = 0; e < 16; ++e) { const float xv = bf2f((unsigned short)((e & 1) ? (xw[e >> 1] >> 16) : (xw[e >> 1] & 0xffffu)));
              const unsigned a = (unsigned)((16 * pg + e) * XROW + 2 * s);
              *(LAS unsigned short*)(size_t)(lds0 + XT_OFF + a) = (unsigned short)f2bf(xv * dts); *(LAS unsigned short*)(size_t)(lds0 + XE_OFF + a) = (unsigned short)f2bf(xv * de); } }
        asm volatile("s_waitcnt vmcnt(0) lgkmcnt(0)\n\ts_barrier" ::: "memory");
        bf16x8 cf[8];
#pragma unroll
        for (int kk = 0; kk < 8; ++kk) cf[kk] = *(const LAS bf16x8*)(size_t)(lds0 + CI_OFF + lt * 8192 + 256 * ql + 16 * ((unsigned)(2 * kk) ^ wq));
        f32x16 yacc = (f32x16){};
#pragma unroll
        for (int kk = 0; kk < 8; ++kk) { const bf16x8 af = *(const LAS bf16x8*)(size_t)(lds0 + SB_OFF + (32 * pt + ql) * XROW + 2 * (16 * kk + 8 * hh));
            yacc = __builtin_amdgcn_mfma_f32_32x32x16_bf16(af, cf[kk], yacc, 0, 0, 0); }
        const float acl = AC[32 * lt + ql];
        yacc *= __builtin_amdgcn_exp2f(acl);
        for (int sb = 0; sb <= lt; ++sb) {
            f32x16 gacc = (f32x16){};
#pragma unroll
            for (int kk = 0; kk < 8; ++kk) { const bf16x8 bfr = *(const LAS bf16x8*)(size_t)(lds0 + BI_OFF + sb * 8192 + 256 * ql + 16 * ((unsigned)(2 * kk) ^ wq));
                gacc = __builtin_amdgcn_mfma_f32_32x32x16_bf16(bfr, cf[kk], gacc, 0, 0, 0); }
            const int lidx = 32 * lt + ql;
#pragma unroll
            for (int g4 = 0; g4 < 4; ++g4) { const int s0 = 32 * sb + 8 * g4 + 4 * hh; const f32x4 as = *(const LAS f32x4*)(size_t)(lds0 + AC_OFF + 4 * s0);
#pragma unroll
                for (int e = 0; e < 4; ++e) { const float f = __builtin_amdgcn_exp2f(acl - as[e]); gacc[4 * g4 + e] = (s0 + e <= lidx) ? gacc[4 * g4 + e] * f : 0.f; } }
#pragma unroll
            for (int s2 = 0; s2 < 2; ++s2) {
                v4u gw; gw.x = cvtpk(gacc[8 * s2], gacc[8 * s2 + 1]); gw.y = cvtpk(gacc[8 * s2 + 2], gacc[8 * s2 + 3]); gw.z = cvtpk(gacc[8 * s2 + 4], gacc[8 * s2 + 5]); gw.w = cvtpk(gacc[8 * s2 + 6], gacc[8 * s2 + 7]);
                const unsigned xa = lds0 + XT_OFF + (unsigned)((32 * pt + ql) * XROW + 2 * (32 * sb + 16 * s2 + 4 * hh));
                const v2u x0 = *(const LAS v2u*)(size_t)xa, x1 = *(const LAS v2u*)(size_t)(xa + 16);
                const v4u xf = (v4u){x0.x, x0.y, x1.x, x1.y};
                yacc = __builtin_amdgcn_mfma_f32_32x32x16_bf16(__builtin_bit_cast(bf16x8, xf), __builtin_bit_cast(bf16x8, gw), yacc, 0, 0, 0); }
        }
        { int le; asm volatile("v_mbcnt_lo_u32_b32 %0, -1, 0\n\tv_mbcnt_hi_u32_b32 %0, -1, %0" : "=v"(le));
          const int qe = le & 31, he = le >> 5; const size_t rowg = (size_t)(r0 + 32 * lt + qe); const int c0 = hd * 64 + 32 * pt + 4 * he;
          const bf16* xp = XACT + rowg * CONVD + c0; const bf16* zp = ZS + rowg * 1024 + c0; bf16* mp = MIX + rowg * DMIX + 1024 + c0;
          const float dsk = d_skip[hd]; float ss = 0.f;
#pragma unroll
          for (int g4 = 0; g4 < 4; ++g4) { const v2u xw = *(const v2u*)(xp + 8 * g4); const v2u zw = *(const v2u*)(zp + 8 * g4); const float z[4] = {bf2f((unsigned short)(zw.x & 0xffffu)), bf2f((unsigned short)(zw.x >> 16)), bf2f((unsigned short)(zw.y & 0xffffu)), bf2f((unsigned short)(zw.y >> 16))};
              const float xv[4] = {bf2f((unsigned short)(xw.x & 0xffffu)), bf2f((unsigned short)(xw.x >> 16)), bf2f((unsigned short)(xw.y & 0xffffu)), bf2f((unsigned short)(xw.y >> 16))}; float o[4];
#pragma unroll
              for (int e = 0; e < 4; ++e) { o[e] = (yacc[4 * g4 + e] + dsk * xv[e]) * z[e]; ss += o[e] * o[e]; }
              v2u w; w.x = cvtpk(o[0], o[1]); w.y = cvtpk(o[2], o[3]); *(v2u*)(mp + 8 * g4) = w; }
          ss += __shfl_xor(ss, 32);
          if (he == 0) atomicAdd(SSQG + rowg * 2 + g, ss); }
        sacc *= __builtin_amdgcn_exp2f(AC[127]);
#pragma unroll
        for (int kk = 0; kk < 8; ++kk) { const bf16x8 af = *(const LAS bf16x8*)(size_t)(lds0 + XE_OFF + (32 * pt + ql) * XROW + 2 * (16 * kk + 8 * hh));
            const unsigned vb = (unsigned)((kk >> 1) * 8192 + 4096 * (kk & 1));
            const s16x4 lo = vtr((vbase[0] + vb) ^ (unsigned)(nt << 6)), hi = vtr((vbase[1] + vb) ^ (unsigned)(nt << 6));
            const bf16x8 bfr = (bf16x8){lo[0], lo[1], lo[2], lo[3], hi[0], hi[1], hi[2], hi[3]};
            sacc = __builtin_amdgcn_mfma_f32_32x32x16_bf16(af, bfr, sacc, 0, 0, 0); }
        AT_BARL();
        if (c < 15) {
#pragma unroll
            for (int r = 0; r < 16; ++r) { const int p = 32 * pt + (r & 3) + 8 * (r >> 2) + 4 * hh;
                *(LAS unsigned short*)(size_t)(lds0 + SB_OFF + p * XROW + 2 * (32 * nt + ql)) = (unsigned short)f2bf(sacc[r]); }
        }
    }
    { float* hp = HOUT + ((size_t)(b * 16 + hd) * 64) * 128 + 32 * nt + ql;
#pragma unroll
      for (int r = 0; r < 16; ++r) hp[(size_t)(32 * pt + (r & 3) + 8 * (r >> 2) + 4 * hh) * 128] = sacc[r]; }
    AT_BARL();
}
__device__ __forceinline__ void ssd_phase(LAS unsigned char* L, const bf16* XACT, const float* DTV, const float* a_log, const float* d_skip, const bf16* ZS, bf16* MIX, float* SSQG, float* HOUT, int wave, int lane) {
    for (int u = blockIdx.x; u < 128; u += gridDim.x) ssd_unit(L, XACT, DTV, a_log, d_skip, ZS, u >> 4, u & 15, MIX, SSQG, HOUT, wave, lane);
    asm volatile("s_waitcnt vmcnt(0) lgkmcnt(0)" ::: "memory");
}
__device__ __forceinline__ void ssd_dec_unit(LAS unsigned char* L, const bf16* __restrict__ XACT, const float* __restrict__ DTV, const float* __restrict__ a_log, const float* __restrict__ d_skip, const bf16* __restrict__ ZS,
                                             const float* __restrict__ h0, int b, int g, bf16* __restrict__ MIX, float* __restrict__ HOUT, unsigned* DROWS, int wave, int lane) {
    const int hd = g * 8 + wave, row = NTOK + b, n4 = lane & 31, pr = lane >> 5;
    const bf16* xr = XACT + (size_t)row * CONVD;
    const float dt = DTV[(size_t)row * 16 + hd], dec = expf(-expf(a_log[hd]) * dt);
    const v2u bw = *(const v2u*)(xr + 1024 + g * 128 + 4 * n4), cw = *(const v2u*)(xr + 1280 + g * 128 + 4 * n4);
    const f32x4 Bv = (f32x4){bf2f((unsigned short)(bw.x & 0xffffu)), bf2f((unsigned short)(bw.x >> 16)), bf2f((unsigned short)(bw.y & 0xffffu)), bf2f((unsigned short)(bw.y >> 16))};
    const f32x4 Cv = (f32x4){bf2f((unsigned short)(cw.x & 0xffffu)), bf2f((unsigned short)(cw.x >> 16)), bf2f((unsigned short)(cw.y & 0xffffu)), bf2f((unsigned short)(cw.y >> 16))};
    const float* hin = h0 + ((size_t)(b * 16 + hd) * 64) * 128 + 4 * n4; float* hout = HOUT + ((size_t)(b * 16 + hd) * 64) * 128 + 4 * n4;
    LAS float* GY = (LAS float*)L + wave * 64;
    const float dsk = d_skip[hd];
#pragma unroll 4
    for (int i = 0; i < 32; ++i) { const int p = 2 * i + pr; const float xv = bf2f(xr[hd * 64 + p]);
        f32x4 h = __builtin_nontemporal_load((const f32x4*)(hin + (size_t)p * 128)); h = h * dec + Bv * (xv * dt);
        __builtin_nontemporal_store(h, (f32x4*)(hout + (size_t)p * 128));
        float y = (h.x * Cv.x + h.y * Cv.y) + (h.z * Cv.z + h.w * Cv.w);
#pragma unroll
        for (int o = 1; o < 32; o <<= 1) y += __shfl_xor(y, o);
        if (n4 == 0) GY[p] = (y + dsk * xv) * bf2f(ZS[(size_t)row * 1024 + hd * 64 + p]); }
    AT_BARL();
    { LAS float* G = (LAS float*)L; const int tid = wave * 64 + lane; const float v = G[tid]; float ss = wave_sum(v * v);
      LAS float* RS = (LAS float*)L + 512; if (lane == 0) RS[wave] = ss;
      AT_BARL();
      float tot = 0.f;
#pragma unroll
      for (int w = 0; w < 8; ++w) tot += RS[w];
      const float rstd = 1.0f / sqrtf(tot * (1.f / 512.f) + EPS);
      MIX[(size_t)row * DMIX + 1024 + g * 512 + tid] = (bf16)f2bf(v * rstd); }
    AT_BARL();
}
__device__ __forceinline__ void ssd_dec_phase(LAS unsigned char* L, const bf16* XACT, const float* DTV, const float* a_log, const float* d_skip, const bf16* ZS, const float* h0, bf16* MIX, float* HOUT, unsigned* DROWS, int wave, int lane) {
    for (int u = blockIdx.x; u < 256; u += gridDim.x) ssd_dec_unit(L, XACT, DTV, a_log, d_skip, ZS, h0, u >> 1, u & 1, MIX, HOUT, DROWS, wave, lane);
    asm volatile("s_waitcnt vmcnt(0) lgkmcnt(0)" ::: "memory");
}
__device__ __forceinline__ void ssd_norm_rows(bf16* MIX, const float* SSQG, int gw, int NGW, int lane) {
    for (int m = gw; m < NTOK; m += NGW) { const float r0 = 1.0f / sqrtf(SSQG[2 * m] * (1.f / 512.f) + EPS), r1 = 1.0f / sqrtf(SSQG[2 * m + 1] * (1.f / 512.f) + EPS);
        v4u* p = (v4u*)(MIX + (size_t)m * DMIX + 1024) + lane;
#pragma unroll
        for (int j = 0; j < 2; ++j) { v4u w = p[64 * j]; const float rs = j ? r1 : r0; unsigned* wp = (unsigned*)&w;
#pragma unroll
            for (int e = 0; e < 4; ++e) wp[e] = pk2(bf2f((unsigned short)(wp[e] & 0xffffu)) * rs, bf2f((unsigned short)(wp[e] >> 16)) * rs);
            p[64 * j] = w; } }
}
}
namespace pg8 {
#define PG8_LAS __attribute__((address_space(3)))
typedef unsigned short bf16_t;
typedef short bf16x8 __attribute__((ext_vector_type(8)));
typedef float f32x4 __attribute__((ext_vector_type(4)));
typedef unsigned u32x4 __attribute__((ext_vector_type(4)));
constexpr int BM = 256, BK = 64, HALF = 128, HTB = HALF * BK * 2  , STAGE_BYTES = 8 * HTB, NXCD = 8, WGM = 8;

__host__ __device__ __forceinline__ int lds_byte(int r, int c) { const int st = (r >> 4) * 2 + (c >> 5), rr = r & 15, cc = c & 31, ob = rr * 64 + cc * 2; return st * 1024 + (ob ^ (((ob >> 9) & 1) << 5)); }
__host__ __device__ __forceinline__ void stage_rc(int b, int& R, int& C) { const int st = b / 1024, sb = b % 1024, swz = sb ^ (((sb >> 9) & 1) << 5); R = (st >> 1) * 16 + swz / 64; C = (st & 1) * 32 + (swz % 64) / 2; }
__host__ __device__ __forceinline__ int perm32(int rho) { const int n = rho >> 4, i = rho & 15; return 8 * (i >> 2) + 4 * n + (i & 3); }

struct Unit { int pm, pn; };
struct Gemm { const bf16_t* A; const bf16_t* Bt; int M, N, K; };

struct StaticOrder {
    int nM, nN, nwg, G, c;
    __host__ __device__ void init(int M, int N, int G_, int c_) { nM = M / BM; nN = N / BM; nwg = nM * nN; G = G_; c = c_; }
    __host__ __device__ bool next(int i, Unit& u) const {
        const long L = (long)i * G + c; if (L >= nwg) return false;
        int wgid = (int)L; { const int q = nwg / NXCD, r = nwg % NXCD, xcd = wgid % NXCD, off = wgid / NXCD; wgid = (xcd < r ? xcd * (q + 1) : r * (q + 1) + (xcd - r) * q) + off; }
        const int nig = WGM * nN, gid = wgid / nig, fm = gid * WGM, gsz = (nM - fm) < WGM ? (nM - fm) : WGM;
        u.pm = fm + ((wgid % nig) % gsz); u.pn = (wgid % nig) / gsz; return true;
    }
    __device__ __forceinline__ void a_ready(const Unit&) const {}
    __device__ __forceinline__ void done(const Unit&) const {}
};

__device__ __forceinline__ unsigned cvt_pk_bf16(float lo, float hi) { unsigned r; asm volatile("v_cvt_pk_bf16_f32 %0, %1, %2" : "=v"(r) : "v"(lo), "v"(hi)); return r; }
typedef float f32x2 __attribute__((ext_vector_type(2)));
template <class Epi, class Sched, bool ALIGN_EPI = false, bool SP2 = false, bool HALF_M = false>
__device__ __forceinline__ void gemm_phase(PG8_LAS unsigned char* lds, const Gemm g, const Sched& S, const Epi& E, int wid_in) {
    int lane; asm volatile("v_mbcnt_lo_u32_b32 %0, -1, 0\n\tv_mbcnt_hi_u32_b32 %0, -1, %0" : "=v"(lane));
    const int wid = wid_in, tid = wid * 64 + lane, wr = wid >> 2, wc = wid & 3, fr = lane & 15, fq = lane >> 4;
    const int K = g.K, nt = K / BK;
    unsigned voffA[2], voffB[2];
#pragma unroll
    for (int i = 0; i < 2; ++i) { int R, C; stage_rc(tid * 16 + i * 8192, R, C); const int Rb = Epi::PERM ? ((R & ~31) + perm32(R & 31)) : R;
        voffA[i] = (unsigned)(R * K + C) * 2u; voffB[i] = (unsigned)(Rb * K + C) * 2u; }
    const size_t kstep = (size_t)(BK * 2);
    const size_t hstep = (size_t)HALF * K * 2;
    const size_t tstep = 2 * hstep;
    const unsigned ldsw = (unsigned)wid * 1024u;
    const int aoff = lds_byte(wr * 64 + fr, fq * 8), boff = lds_byte(wc * 32 + fr, fq * 8);
#define PG8_SA(b, h) (((b) * 2 + (h)) * HTB)
#define PG8_SB(b, h) ((4 + (b) * 2 + (h)) * HTB)
#define PG8_STAGE(bufoff, gbase, voff) do { _Pragma("unroll") for (int _i = 0; _i < 2; ++_i) { unsigned _vo = (voff)[_i]; asm volatile("" : "+v"(_vo));   \
        __builtin_amdgcn_global_load_lds((const unsigned*)((const char*)(gbase) + _vo), (PG8_LAS unsigned*)(lds + (bufoff) + ldsw + _i * 8192), 16, 0, 0); } } while (0)
#define PG8_LDA(dst, b, h) do { _Pragma("unroll") for (int m = 0; m < 4; ++m) _Pragma("unroll") for (int k = 0; k < 2; ++k) dst[m][k] = *(const PG8_LAS bf16x8*)(lds + PG8_SA(b, h) + aoff + m * 2048 + k * 1024); } while (0)
#define PG8_LDB(dst, b, h) do { _Pragma("unroll") for (int n = 0; n < 2; ++n) _Pragma("unroll") for (int k = 0; k < 2; ++k) dst[n][k] = *(const PG8_LAS bf16x8*)(lds + PG8_SB(b, h) + boff + n * 2048 + k * 1024); } while (0)
#define PG8_MMA(ai, bj, At, Bt) do { __builtin_amdgcn_s_setprio(1); _Pragma("unroll") for (int m = 0; m < 4; ++m) _Pragma("unroll") for (int n = 0; n < 2; ++n) _Pragma("unroll") for (int k = 0; k < 2; ++k) \
        acc[ai][bj][m][n] = __builtin_amdgcn_mfma_f32_16x16x32_bf16(Bt[n][k], At[m][k], acc[ai][bj][m][n], 0, 0, 0); __builtin_amdgcn_s_setprio(0); } while (0)
#define PG8_WAIT_V(n) asm volatile("s_waitcnt vmcnt(" #n ")" ::: "memory")
#define PG8_WAIT_L(n) asm volatile("s_waitcnt lgkmcnt(" #n ")" ::: "memory")
#define PG8_BAR __builtin_amdgcn_s_barrier()
#define PG8_SCHED __builtin_amdgcn_sched_barrier(0)
    Unit cur, nxt; int ui = 0;
    if (!S.next(0, cur)) return;
    f32x4 acc[2][2][4][2];
#pragma unroll
    for (int a = 0; a < 2; ++a)
#pragma unroll
        for (int b = 0; b < 2; ++b)
#pragma unroll
            for (int m = 0; m < 4; ++m)
#pragma unroll
                for (int n = 0; n < 2; ++n) acc[a][b][m][n] = (f32x4){0.f, 0.f, 0.f, 0.f};
    bf16x8 At[4][2], B0[2][2], B1[2][2];
    const char* cA = (const char*)g.A + (size_t)cur.pm * tstep; const char* cB = (const char*)g.Bt + (size_t)cur.pn * tstep;
    S.a_ready(cur);
    if constexpr (SP2) {
        PG8_STAGE(PG8_SB(0, 0), cB, voffB); PG8_STAGE(PG8_SB(0, 1), cB + hstep, voffB); PG8_STAGE(PG8_SA(0, 0), cA, voffA); PG8_STAGE(PG8_SA(0, 1), cA + hstep, voffA);
        if (wr == 1) PG8_BAR;
        PG8_WAIT_V(2); PG8_BAR;
        PG8_STAGE(PG8_SB(1, 0), cB + kstep, voffB); PG8_STAGE(PG8_SA(1, 0), cA + kstep, voffA); PG8_STAGE(PG8_SB(1, 1), cB + hstep + kstep, voffB);
        PG8_WAIT_V(6); PG8_BAR;
    } else {
        PG8_STAGE(PG8_SB(0, 0), cB, voffB); PG8_STAGE(PG8_SA(0, 0), cA, voffA); PG8_STAGE(PG8_SB(0, 1), cB + hstep, voffB); PG8_STAGE(PG8_SA(0, 1), cA + hstep, voffA);
        if (wr == 1) PG8_BAR;
        PG8_WAIT_V(4); PG8_BAR;
        PG8_STAGE(PG8_SB(1, 0), cB + kstep, voffB); PG8_STAGE(PG8_SA(1, 0), cA + kstep, voffA); PG8_STAGE(PG8_SB(1, 1), cB + hstep + kstep, voffB);
        PG8_WAIT_V(6); PG8_BAR;
    }
    for (;;) {
        const bool has_next = S.next(ui + 1, nxt);
        const char* nA = has_next ? (const char*)g.A + (size_t)nxt.pm * tstep : cA; const char* nB = has_next ? (const char*)g.Bt + (size_t)nxt.pn * tstep : cB;
        for (int t = 0; t < nt; t += 2) {
            const bool last = (t == nt - 2);
            const char* a1 = cA + (size_t)(t + 1) * kstep;
            const char* a2 = last ? nA : cA + (size_t)(t + 2) * kstep; const char* b2 = last ? nB : cB + (size_t)(t + 2) * kstep;
            const char* a3 = a2 + kstep; const char* b3 = b2 + kstep;
            if (last && has_next) S.a_ready(nxt);
            if constexpr (SP2) {
            PG8_LDB(B0, 0, 0); PG8_LDB(B1, 0, 1); PG8_SCHED; PG8_LDA(At, 0, 0); PG8_STAGE(PG8_SA(1, 1), a1 + hstep, voffA);
            PG8_WAIT_V(8); PG8_WAIT_L(0); PG8_BAR; PG8_MMA(0, 0, At, B0); PG8_MMA(0, 1, At, B1); PG8_BAR; PG8_SCHED;
            PG8_LDA(At, 0, 1); PG8_STAGE(PG8_SB(0, 0), b2, voffB); PG8_STAGE(PG8_SB(0, 1), b2 + hstep, voffB); PG8_STAGE(PG8_SA(0, 0), a2, voffA);
            PG8_WAIT_V(8); PG8_WAIT_L(0); PG8_BAR; if constexpr (!HALF_M) { PG8_MMA(1, 0, At, B0); PG8_MMA(1, 1, At, B1); } PG8_BAR; PG8_SCHED;
            PG8_LDB(B0, 1, 0); PG8_LDB(B1, 1, 1); PG8_SCHED; PG8_LDA(At, 1, 0); PG8_STAGE(PG8_SA(0, 1), a2 + hstep, voffA);
            PG8_WAIT_V(8); PG8_WAIT_L(0); PG8_BAR; PG8_MMA(0, 0, At, B0); PG8_MMA(0, 1, At, B1); PG8_BAR; PG8_SCHED;
            PG8_LDA(At, 1, 1); PG8_STAGE(PG8_SB(1, 0), b3, voffB); PG8_STAGE(PG8_SB(1, 1), b3 + hstep, voffB); PG8_STAGE(PG8_SA(1, 0), a3, voffA);
            PG8_WAIT_V(8); PG8_WAIT_L(0); PG8_BAR; if constexpr (!HALF_M) { PG8_MMA(1, 0, At, B0); PG8_MMA(1, 1, At, B1); } PG8_BAR; PG8_SCHED;
            } else {
            PG8_LDB(B0, 0, 0); PG8_SCHED; PG8_LDA(At, 0, 0); PG8_STAGE(PG8_SA(1, 1), a1 + hstep, voffA);
            PG8_WAIT_L(8); PG8_BAR; PG8_WAIT_L(0); PG8_MMA(0, 0, At, B0); PG8_BAR; PG8_SCHED;
            PG8_LDB(B1, 0, 1); PG8_STAGE(PG8_SB(0, 0), b2, voffB);
            PG8_BAR; PG8_WAIT_L(0); PG8_MMA(0, 1, At, B1); PG8_BAR;
            PG8_LDA(At, 0, 1); PG8_STAGE(PG8_SA(0, 0), a2, voffA);
            PG8_BAR; PG8_WAIT_L(0); PG8_MMA(1, 0, At, B0); PG8_BAR; PG8_SCHED;
            PG8_STAGE(PG8_SB(0, 1), b2 + hstep, voffB);
            PG8_WAIT_V(6); PG8_BAR; PG8_MMA(1, 1, At, B1); PG8_BAR;
            PG8_LDB(B0, 1, 0); PG8_SCHED; PG8_LDA(At, 1, 0); PG8_STAGE(PG8_SA(0, 1), a2 + hstep, voffA);
            PG8_WAIT_L(8); PG8_BAR; PG8_WAIT_L(0); PG8_MMA(0, 0, At, B0); PG8_BAR; PG8_SCHED;
            PG8_LDB(B1, 1, 1); PG8_STAGE(PG8_SB(1, 0), b3, voffB);
            PG8_BAR; PG8_WAIT_L(0); PG8_MMA(0, 1, At, B1); PG8_BAR;
            PG8_LDA(At, 1, 1); PG8_STAGE(PG8_SA(1, 0), a3, voffA);
            PG8_BAR; PG8_WAIT_L(0); PG8_MMA(1, 0, At, B0); PG8_BAR; PG8_SCHED;
            PG8_STAGE(PG8_SB(1, 1), b3 + hstep, voffB);
            PG8_WAIT_V(6); PG8_BAR; PG8_MMA(1, 1, At, B1); PG8_BAR;
            }
        }
        if constexpr (ALIGN_EPI) { if (wr == 0) PG8_BAR; }
        if constexpr (!Epi::AFTER_DRAIN) { E(acc, cur, wr, wc, fr, fq); S.done(cur); }
        if (!has_next) break;
#pragma unroll
        for (int a = 0; a < 2; ++a)
#pragma unroll
            for (int b = 0; b < 2; ++b)
#pragma unroll
                for (int m = 0; m < 4; ++m)
#pragma unroll
                    for (int n = 0; n < 2; ++n) acc[a][b][m][n] = (f32x4){0.f, 0.f, 0.f, 0.f};
        cur = nxt; cA = nA; cB = nB; ++ui;
        if constexpr (ALIGN_EPI) { if (wr == 1) PG8_BAR; }
    }
    PG8_WAIT_V(0);
    if constexpr (!ALIGN_EPI) { if (wr == 0) PG8_BAR; }
    PG8_BAR;
    if constexpr (Epi::AFTER_DRAIN) { E.fused(acc, cur, wr, wc, fr, fq, lds, wid, lane); S.done(cur); }
#undef PG8_SA
#undef PG8_SB
#undef PG8_STAGE
#undef PG8_LDA
#undef PG8_LDB
#undef PG8_MMA
#undef PG8_WAIT_V
#undef PG8_WAIT_L
#undef PG8_BAR
#undef PG8_SCHED
}
struct EpiF32Clip {
    static constexpr bool PERM = false, AFTER_DRAIN = false;
    float* O; int ldc, Mv, Nv;
    __device__ __forceinline__ void operator()(const f32x4 (&acc)[2][2][4][2], const Unit& u, int wr, int wc, int fr, int fq) const {
        { int l_; asm volatile("v_mbcnt_lo_u32_b32 %0, -1, 0\n\tv_mbcnt_hi_u32_b32 %0, -1, %0" : "=v"(l_)); fr = l_ & 15; fq = l_ >> 4; }
#pragma unroll
        for (int ai = 0; ai < 2; ++ai)
#pragma unroll
            for (int m = 0; m < 4; ++m) { const int row = u.pm * BM + ai * HALF + wr * 64 + m * 16 + fr; if (row >= Mv) continue;
#pragma unroll
                for (int bj = 0; bj < 2; ++bj)
#pragma unroll
                    for (int n = 0; n < 2; ++n) { const int col = u.pn * BM + bj * HALF + wc * 32 + n * 16 + 4 * fq; if (col < Nv) *(f32x4*)(O + (size_t)row * ldc + col) = acc[ai][bj][m][n]; } }
    }
};
struct EpiProj {
    static constexpr bool PERM = false, AFTER_DRAIN = false;
    bf16_t* QA; float* ssq; float* ckv_p; float* ckv_s; float* KR; bf16_t* ZA; bf16_t* ZS; bf16_t* XB; float* conv_p; float* conv_s; float* DT;
    __device__ __forceinline__ void operator()(const f32x4 (&acc)[2][2][4][2], const Unit& u, int wr, int wc, int fr, int fq) const {
        { int l_; asm volatile("v_mbcnt_lo_u32_b32 %0, -1, 0\n\tv_mbcnt_hi_u32_b32 %0, -1, %0" : "=v"(l_)); fr = l_ & 15; fq = l_ >> 4; }
        typedef unsigned u32x2 __attribute__((ext_vector_type(2)));
#pragma unroll
        for (int bj = 0; bj < 2; ++bj) { const int cb = u.pn * BM + bj * HALF + wc * 32;
            const int reg = cb < 384 ? 0 : cb < 640 ? 1 : cb < 704 ? 2 : cb < 1728 ? 3 : cb < 2752 ? 4 : cb < 4288 ? 5 : cb < 4304 ? 6 : 7;
            if (reg == 7) continue;
#pragma unroll
            for (int ai = 0; ai < 2; ++ai)
#pragma unroll
                for (int m = 0; m < 4; ++m) { const int row = u.pm * BM + ai * HALF + wr * 64 + m * 16 + fr; const bool rok = row < 16512; float ss = 0.f;
#pragma unroll
                    for (int n = 0; n < 2; ++n) { const int c = cb + n * 16 + 4 * fq; const f32x4 v = acc[ai][bj][m][n];
                        if (reg == 0) { ss += (v[0] * v[0] + v[1] * v[1]) + (v[2] * v[2] + v[3] * v[3]); if (rok) { u32x2 w; w.x = cvt_pk_bf16(v[0], v[1]); w.y = cvt_pk_bf16(v[2], v[3]); *(u32x2*)(QA + (size_t)row * 384 + c) = w; } }
                        else if (reg == 1) { if (rok) *(f32x4*)((row < 16384 ? ckv_p + (size_t)row * 256 : ckv_s + (size_t)(row - 16384) * 256) + (c - 384)) = v; }
                        else if (reg == 2) { if (rok) *(f32x4*)(KR + (size_t)row * 64 + (c - 640)) = v; }
                        else if (reg == 3 || reg == 4) { if (rok) { f32x4 g;
#pragma unroll
                                for (int e = 0; e < 4; ++e) g[e] = v[e] / (1.0f + __expf(-v[e]));
                                u32x2 w; w.x = cvt_pk_bf16(g[0], g[1]); w.y = cvt_pk_bf16(g[2], g[3]);
                                *(u32x2*)((reg == 3 ? ZA + (size_t)row * 1024 + (c - 704) : ZS + (size_t)row * 1024 + (c - 1728))) = w; } }
                        else if (reg == 5) { if (rok) { u32x2 w; w.x = cvt_pk_bf16(v[0], v[1]); w.y = cvt_pk_bf16(v[2], v[3]); *(u32x2*)(XB + (size_t)row * 1536 + (c - 2752)) = w;
                                if (row >= 16384) *(f32x4*)(conv_s + ((size_t)(row - 16384) * 3 + 2) * 1536 + (c - 2752)) = v;
                                else if ((row & 2047) >= 2045) *(f32x4*)(conv_p + ((size_t)(row >> 11) * 3 + ((row & 2047) - 2045)) * 1536 + (c - 2752)) = v; } }
                        else { if (rok && c < 4304) *(f32x4*)(DT + (size_t)row * 16 + (c - 4288)) = v; } }
                    if (reg == 0) { ss += __shfl_xor(ss, 16); ss += __shfl_xor(ss, 32); if (fq == 0 && rok) atomicAdd(ssq + row, ss); }
                    if (m & 1) asm volatile("" ::: "memory"); } }
    }
};
struct EpiQ {
    static constexpr bool PERM = true, AFTER_DRAIN = false;
    bf16_t* QB; const float* ssq; const float* tab; float qscale; int Mv;
    __device__ __forceinline__ void operator()(const f32x4 (&acc)[2][2][4][2], const Unit& u, int wr, int wc, int fr, int fq) const {
        { int l_; asm volatile("v_mbcnt_lo_u32_b32 %0, -1, 0\n\tv_mbcnt_hi_u32_b32 %0, -1, %0" : "=v"(l_)); fr = l_ & 15; fq = l_ >> 4; }
#pragma unroll
        for (int ai = 0; ai < 2; ++ai)
#pragma unroll
            for (int m = 0; m < 4; ++m) { const int row = u.pm * BM + ai * HALF + wr * 64 + m * 16 + fr; if (row >= Mv) continue;
                const float rs = qscale / sqrtf(ssq[row] * (1.f / 384.f) + 1e-6f); const int pidx = row < 16384 ? (row & 2047) : 2048;
#pragma unroll
                for (int bj = 0; bj < 2; ++bj) { const int cg = u.pn * BM + bj * HALF + wc * 32 + 8 * fq, h = cg / 320, cc = cg - h * 320;
                    const f32x4 v0 = acc[ai][bj][m][0] * rs, v1 = acc[ai][bj][m][1] * rs; bf16_t* dst = QB + (size_t)row * 2560 + h * 320;
                    if (cc < 256) { u32x4 w; w.x = cvt_pk_bf16(v0[0], v0[1]); w.y = cvt_pk_bf16(v0[2], v0[3]); w.z = cvt_pk_bf16(v1[0], v1[1]); w.w = cvt_pk_bf16(v1[2], v1[3]); *(u32x4*)(dst + cc) = w; }
                    else { const int j0 = (cc - 256) >> 1; const f32x4 c4 = *(const f32x4*)(tab + pidx * 64 + j0), s4 = *(const f32x4*)(tab + pidx * 64 + 32 + j0);
                        const float a0 = v0[0] * c4[0] - v0[1] * s4[0], b0 = v0[0] * s4[0] + v0[1] * c4[0], a1 = v0[2] * c4[1] - v0[3] * s4[1], b1 = v0[2] * s4[1] + v0[3] * c4[1];
                        const float a2 = v1[0] * c4[2] - v1[1] * s4[2], b2 = v1[0] * s4[2] + v1[1] * c4[2], a3 = v1[2] * c4[3] - v1[3] * s4[3], b3 = v1[2] * s4[3] + v1[3] * c4[3];
                        typedef unsigned u32x2 __attribute__((ext_vector_type(2)));
                        u32x2 wa, wb; wa.x = cvt_pk_bf16(a0, a1); wa.y = cvt_pk_bf16(a2, a3); wb.x = cvt_pk_bf16(b0, b1); wb.y = cvt_pk_bf16(b2, b3);
                        *(u32x2*)(dst + 256 + j0) = wa; *(u32x2*)(dst + 288 + j0) = wb; } }
                asm volatile("" ::: "memory"); }
    }
};
struct EpiOutSsq {
    static constexpr bool PERM = false, AFTER_DRAIN = false;
    float* O; float* ssq; int ldc, Mv;
    __device__ __forceinline__ void operator()(const f32x4 (&acc)[2][2][4][2], const Unit& u, int wr, int wc, int fr, int fq) const {
        { int l_; asm volatile("v_mbcnt_lo_u32_b32 %0, -1, 0\n\tv_mbcnt_hi_u32_b32 %0, -1, %0" : "=v"(l_)); fr = l_ & 15; fq = l_ >> 4; }
#pragma unroll
        for (int ai = 0; ai < 2; ++ai)
#pragma unroll
            for (int m = 0; m < 4; ++m) { const int row = u.pm * BM + ai * HALF + wr * 64 + m * 16 + fr; float s = 0.f;
#pragma unroll
                for (int bj = 0; bj < 2; ++bj)
#pragma unroll
                    for (int n = 0; n < 2; ++n) { const f32x4 v = acc[ai][bj][m][n]; s += (v[0] * v[0] + v[1] * v[1]) + (v[2] * v[2] + v[3] * v[3]);
                        if (row < Mv) *(f32x4*)(O + (size_t)row * ldc + u.pn * BM + bj * HALF + wc * 32 + n * 16 + 4 * fq) = v; }
                s += __shfl_xor(s, 16); s += __shfl_xor(s, 32);
                if (fq == 0 && row < Mv) atomicAdd(ssq + row, s); }
    }
};
struct OneUnit {
    int pm, pn;
    __device__ __forceinline__ bool next(int i, Unit& u) const { if (i != 0) return false; u.pm = pm; u.pn = pn; return true; }
    __device__ __forceinline__ void a_ready(const Unit&) const {}
    __device__ __forceinline__ void done(const Unit&) const {}
};
}
constexpr int NWAVES = 8;
constexpr int LDS_BYTES = 147456;
constexpr int LDSCTL_OFF = 143360, MISC_OFF = LDSCTL_OFF + 320;
constexpr size_t WS_CTL = 0, CTL_ZERO_BYTES = 1u << 20;
constexpr int CW_BAR = 4096;
constexpr size_t WS_OUTP = (size_t)448 << 20;
struct Args { const void* in[22]; float* out; unsigned char* ws; int ph_lo, ph_hi; };

__global__ void __launch_bounds__(NWAVES * 64, 2) mega_fwd(Args args) {
    extern __shared__ __attribute__((aligned(16))) unsigned char lds[];
    LAS unsigned char* L = (LAS unsigned char*)lds;
    for (int u = threadIdx.x; u < (LDS_BYTES - LDSCTL_OFF) / 4; u += NWAVES * 64) ((LAS unsigned*)(L + LDSCTL_OFF))[u] = 0u;
    __syncthreads();
    unsigned* ctl = (unsigned*)(args.ws + WS_CTL);
    XcdBarrier bar = xcd_barrier_post(ctl + CW_BAR, (volatile LAS unsigned*)(L + MISC_OFF) + 8);
    const int lo = args.ph_lo, hi = args.ph_hi;
#define IN(k) (lo <= (k) && (k) < hi)
#define SEAM(k) do { if (IN(k) && IN((k) + 1)) xcd_barrier(bar); } while (0)
    using namespace nv;
    const float* x_p = (const float*)args.in[0]; const float* x_s = (const float*)args.in[1]; const float* cache_ckv = (const float*)args.in[2]; const float* cache_kr = (const float*)args.in[3];
    const float* state_conv = (const float*)args.in[4]; const float* state_ssm = (const float*)args.in[5]; const int* page_table = (const int*)args.in[6];
    const float* norm_pre = (const float*)args.in[7]; const float* w_in = (const float*)args.in[8]; const float* q_a_norm = (const float*)args.in[9]; const float* w_q_b = (const float*)args.in[10];
    const float* kv_a_norm = (const float*)args.in[11]; const float* w_uk = (const float*)args.in[12]; const float* w_uv = (const float*)args.in[13]; const float* conv_w = (const float*)args.in[14];
    const float* conv_b = (const float*)args.in[15]; const float* dt_bias = (const float*)args.in[16]; const float* a_log = (const float*)args.in[17]; const float* d_skip = (const float*)args.in[18];
    const float* ssm_norm = (const float*)args.in[19]; const float* w_out = (const float*)args.in[20]; const float* norm_post = (const float*)args.in[21];
    float* out = args.out;
    float* y_p = out; float* y_s = y_p + (size_t)NTOK * 1024; float* ckv_p = y_s + (size_t)DEC * 1024; float* kr_p = ckv_p + (size_t)NTOK * 256; float* conv_p = kr_p + (size_t)NTOK * 64;
    float* ssm_p = conv_p + (size_t)BATCH * 3 * CONVD; float* ckv_s = ssm_p + (size_t)BATCH * 16 * 64 * 128; float* kr_s = ckv_s + (size_t)DEC * 256; float* conv_s = kr_s + (size_t)DEC * 64;
    float* ssm_s = conv_s + (size_t)DEC * 3 * CONVD;
    unsigned char* ws = args.ws;
    mk::bf16* WIN = (mk::bf16*)(ws + mk::WS_WIN); mk::bf16* XN = (mk::bf16*)(ws + mk::WS_XN); mk::bf16* WQ = (mk::bf16*)(ws + mk::WS_WQ); float* TAB = (float*)(ws + mk::WS_TAB);
    mk::bf16* QA = (mk::bf16*)(ws + mk::WS_QA); mk::bf16* KB = (mk::bf16*)(ws + mk::WS_KB); float* DTV = (float*)(ws + mk::WS_DTV); mk::bf16* QB = (mk::bf16*)(ws + mk::WS_QB);
    mk::bf16* XACT = (mk::bf16*)(ws + mk::WS_XACT); mk::bf16* WOUT = (mk::bf16*)(ws + mk::WS_WOUT); mk::bf16* MIXB = (mk::bf16*)(ws + mk::WS_MIX); mk::bf16* WUVF = (mk::bf16*)(ws + at::WS_WUVF);
    float* KRR = (float*)(ws + mk::WS_KRR); float* DTR = (float*)(ws + mk::WS_DTR); mk::bf16* XBR = (mk::bf16*)(ws + mk::WS_XBR); mk::bf16* ZA = (mk::bf16*)(ws + mk::WS_ZA); mk::bf16* ZS = (mk::bf16*)(ws + mk::WS_ZS);
    float* SSQ = (float*)(ws + mk::CTL_SSQ); float* SSQ2 = (float*)(ws + mk::CTL_SSQ2); float* SSQG = (float*)(ws + mk::CTL_SSQG); float* OUTP = (float*)(ws + WS_OUTP);
    const int wave_s = __builtin_amdgcn_readfirstlane(threadIdx.x >> 6);
#define TID() ({ int l_; asm volatile("v_mbcnt_lo_u32_b32 %0, -1, 0\n\tv_mbcnt_hi_u32_b32 %0, -1, %0" : "=v"(l_)); wave_s * 64 + l_; })
    const int gw = blockIdx.x * NWAVES + wave_s, NGW = gridDim.x * NWAVES;

    if (IN(0)) {
        const int lane = TID() & 63; LAS float* scr = (LAS float*)(L + wave_s * 16384);
        for (int it = gw; it < 16 * (mk::N1P / 32); it += NGW) mk::p0_transpose_item(w_in, 1024, NPROJ, norm_pre, 0, WIN, 0, scr, it, mk::N1P / 32, lane);
        for (int it = (gw + NGW - 128) % NGW; it < 32 * 32; it += NGW) mk::p0_transpose_item(w_out, 2048, 1024, ssm_norm, 1024, WOUT, 0, scr, it, 32, lane);
        for (int it = (gw + NGW - 1152) % NGW; it < 512; it += NGW) at::wuvf_item(w_uv, WUVF, it, lane);
        for (int it = (gw + NGW - 1664) % NGW; it < 768; it += NGW) mk::wq_lat_item(w_q_b, w_uk, q_a_norm, WQ, it, lane);
        for (int it = (gw + NGW - 400) % NGW; it < 512; it += NGW) mk::wq_rope_item(w_q_b, q_a_norm, WQ, it, lane);
        for (int it = blockIdx.x * 512 + TID(); it < 2049 * 32; it += gridDim.x * 512) mk::tab_item(TAB, it);
        for (size_t i = (size_t)blockIdx.x * 512 + TID(); i < (size_t)(mk::MP - MT) * 1024; i += (size_t)gridDim.x * 512) ((unsigned*)MIXB)[(size_t)MT * 1024 + i] = 0u;
        for (int m = gw; m < NTOK; m += 2 * NGW) { const int m2 = m + NGW;
            if (m2 < NTOK) mk::xn_row2(x_p + (size_t)m * 1024, x_p + (size_t)m2 * 1024, XN + (size_t)m * 1024, XN + (size_t)m2 * 1024, lane);
            else mk::xn_row(x_p + (size_t)m * 1024, XN + (size_t)m * 1024, lane); }
        for (int m = NTOK + gw; m < mk::MP; m += NGW) mk::xn_row(m < MT ? x_s + (size_t)(m - NTOK) * 1024 : nullptr, XN + (size_t)m * 1024, lane);
    }
    SEAM(0);
    if (IN(1)) {
        pg8::Gemm g{(const pg8::bf16_t*)XN, (const pg8::bf16_t*)WIN, mk::MP, mk::N1P, 1024}; pg8::StaticOrder S; S.init(mk::MP, mk::N1P, gridDim.x, (int)blockIdx.x);
        pg8::EpiProj E{(pg8::bf16_t*)QA, SSQ, ckv_p, ckv_s, KRR, (pg8::bf16_t*)ZA, (pg8::bf16_t*)ZS, (pg8::bf16_t*)XBR, conv_p, conv_s, DTR};
        pg8::gemm_phase<pg8::EpiProj, pg8::StaticOrder, true, true>(L, g, S, E, wave_s);
    }
    SEAM(1);
    if (IN(2)) {
        { const int lane = TID() & 63;
          for (int rr = gw; rr < NTOK / 8; rr += NGW) mk::p2_run(rr, lane, KRR, DTR, XBR, kv_a_norm, TAB, dt_bias, conv_w, conv_b, KB, DTV, XACT, ckv_p, kr_p);
          for (int m = NTOK + gw; m < MT; m += NGW) mk::p2_row(m, lane, KRR, DTR, XBR, kv_a_norm, TAB, dt_bias, conv_w, conv_b, state_conv, KB, DTV, XACT, ckv_p, ckv_s, kr_p, kr_s, conv_s); }
        pg8::Gemm g{(const pg8::bf16_t*)QA, (const pg8::bf16_t*)WQ, mk::MP, 2560, 384}; pg8::StaticOrder S; S.init(mk::MP, 2560, gridDim.x, (int)blockIdx.x);
        pg8::EpiQ E{(pg8::bf16_t*)QB, SSQ, TAB, mk::QSCALE, MT};
        pg8::gemm_phase<pg8::EpiQ, pg8::StaticOrder, true, true>(L, g, S, E, wave_s);
    }
    SEAM(2);
    if (IN(3)) {
        unsigned* DROWS = (unsigned*)(ws + dc::CTL_DROWS);
        __syncthreads();
        sd::ssd_phase(L, XACT, DTV, a_log, d_skip, ZS, MIXB, SSQG, ssm_p, wave_s, TID() & 63);
        __syncthreads();
        at::attn_phase(L, QB, KB, WUVF, ZA, MIXB, wave_s, TID() & 63);
        __syncthreads();
        dc::dec_phase(L, QB, KB, cache_ckv, cache_kr, page_table, ws, w_uv, ZA, MIXB, wave_s, TID() & 63);
        __syncthreads();
        sd::ssd_dec_phase(L, XACT, DTV, a_log, d_skip, ZS, state_ssm, MIXB, ssm_s, DROWS, wave_s, TID() & 63);
    }
    SEAM(3);
    if (IN(4)) {
        if ((int)blockIdx.x >= (int)gridDim.x - 4) {
            pg8::Gemm g{(const pg8::bf16_t*)MIXB, (const pg8::bf16_t*)WOUT, mk::MP, 1024, 2048}; pg8::OneUnit S{64, (int)blockIdx.x - ((int)gridDim.x - 4)};
            pg8::EpiOutSsq E{OUTP, SSQ2, 1024, MT};
            pg8::gemm_phase<pg8::EpiOutSsq, pg8::OneUnit, true, true, true>(L, g, S, E, wave_s);
        } else { const int nb = (int)gridDim.x - 4; sd::ssd_norm_rows(MIXB, SSQG, blockIdx.x * NWAVES + wave_s, nb * NWAVES, TID() & 63); }
    }
    SEAM(4);
    if (IN(5)) {
        pg8::Gemm g{(const pg8::bf16_t*)MIXB, (const pg8::bf16_t*)WOUT, NTOK, 1024, 2048}; pg8::StaticOrder S; S.init(NTOK, 1024, gridDim.x, (int)blockIdx.x);
        pg8::EpiOutSsq E{OUTP, SSQ2, 1024, MT};
        pg8::gemm_phase<pg8::EpiOutSsq, pg8::StaticOrder, true, true>(L, g, S, E, wave_s);
    }
    SEAM(5);
    if (IN(6)) {
        const int lane = TID() & 63;
        for (int m = gw; m < MT; m += NGW) { const float rstd = 1.0f / sqrtf(SSQ2[m] * (1.f / 1024.f) + EPS);
            const float* xr = m < NTOK ? x_p + (size_t)m * 1024 : x_s + (size_t)(m - NTOK) * 1024; float* yr = m < NTOK ? y_p + (size_t)m * 1024 : y_s + (size_t)(m - NTOK) * 1024;
#pragma unroll
            for (int jj = 0; jj < 4; ++jj) { const int c = 4 * lane + 256 * jj; const mk::f32x4 o = *(const mk::f32x4*)(OUTP + (size_t)m * 1024 + c), xx = *(const mk::f32x4*)(xr + c), w = *(const mk::f32x4*)(norm_post + c);
                *(mk::f32x4*)(yr + c) = xx + o * rstd * w; } }
    }
#undef IN
#undef SEAM
}
constexpr int N_PHASES = 7;
#ifndef MK_PER_PHASE
#define MK_PER_PHASE 0
#endif
extern "C" void kernel_launch(void* const* d_in, const int* in_sizes, int n_in, void* d_out, int out_size, void* d_ws, size_t ws_size, hipStream_t stream) {
    static int grid = 0;
    if (grid == 0) {
        int dev = 0, cus = 0;
        if (hipGetDevice(&dev) != hipSuccess || hipDeviceGetAttribute(&cus, hipDeviceAttributeMultiprocessorCount, dev) != hipSuccess) { grid = -1; return; }
        if (hipFuncSetAttribute((const void*)mega_fwd, hipFuncAttributeMaxDynamicSharedMemorySize, LDS_BYTES) != hipSuccess) { fprintf(stderr, "kernel_launch: hipFuncSetAttribute failed\n"); grid = -1; return; }
        int per_cu = 0;
        if (hipOccupancyMaxActiveBlocksPerMultiprocessor(&per_cu, (const void*)mega_fwd, NWAVES * 64, LDS_BYTES) != hipSuccess || per_cu < 1) fprintf(stderr, "kernel_launch: occupancy query says %d\n", per_cu);
        (void)hipGetLastError();
        grid = cus;
    }
    if (grid < 0) return;
    (void)hipMemsetAsync((char*)d_ws + WS_CTL, 0, CTL_ZERO_BYTES, stream);
    Args a{};
    for (int i = 0; i < 22; ++i) a.in[i] = d_in[i];
    a.out = (float*)d_out; a.ws = (unsigned char*)d_ws;
#if MK_PER_PHASE
    for (int p = 0; p < N_PHASES; ++p) { a.ph_lo = p; a.ph_hi = p + 1; hipLaunchKernelGGL(mega_fwd, dim3(grid), dim3(NWAVES * 64), LDS_BYTES, stream, a); }
#else
    a.ph_lo = 0; a.ph_hi = N_PHASES;
    hipLaunchKernelGGL(mega_fwd, dim3(grid), dim3(NWAVES * 64), LDS_BYTES, stream, a);
#endif
}
```
